# Optimizing an MI355X kernel written in HIP

```python
import math
import jax, jax.numpy as jnp
from jax import lax
import numpy as np

D_MODEL = 2048
BATCH = 2
SEQ = 16384
DEPTH = 1

HEAD_DIM = 128
A_HEADS = 8
A_WIDTH = A_HEADS * HEAD_DIM
IDX_HEADS = 16
IDX_DIM = 64
TOPK_MAX = 256
B_HEADS = 4
B_WIDTH = B_HEADS * 2 * HEAD_DIM
Q_BLOCK = 128
ROPE_THETA = 10000.0
NORM_EPS = 1e-6
SUBLN_EPS = 1e-5

SPLIT_SIZES = (
    A_WIDTH, A_WIDTH, A_WIDTH, A_WIDTH,
    IDX_HEADS * IDX_DIM, IDX_DIM, IDX_HEADS,
    B_WIDTH, B_WIDTH, B_WIDTH, B_WIDTH,
    D_MODEL, D_MODEL,
)
IN_COLS = sum(SPLIT_SIZES)

kernel_name = 'hybrid_dsa_diffattn_gated_merge'


def rms_norm(x, gain, eps=NORM_EPS):
    xf = x.astype(jnp.float32)
    y = xf * lax.rsqrt(jnp.mean(xf * xf, axis=-1, keepdims=True) + eps)
    return (y * gain.astype(jnp.float32)).astype(x.dtype)


def rope_tables(positions, dim):
    inv_freq = ROPE_THETA ** (-jnp.arange(0, dim, 2, dtype=jnp.float32) / dim)
    ang = positions.astype(jnp.float32)[..., None] * inv_freq
    return jnp.cos(ang), jnp.sin(ang)


def apply_rope(x, cos, sin):
    shape = cos.shape[:2] + (1,) * (x.ndim - 3) + cos.shape[-1:]
    c = cos.reshape(shape).astype(x.dtype)
    s = sin.reshape(shape).astype(x.dtype)
    x1, x2 = jnp.split(x, 2, axis=-1)
    return jnp.concatenate([x1 * c - x2 * s, x2 * c + x1 * s], axis=-1)


def setup_inputs(seed: int = 0) -> dict:
    key = jax.random.key(seed)
    ks = jax.random.split(key, 16)
    f32 = jnp.float32
    x = jax.random.normal(ks[0], (BATCH, SEQ, D_MODEL), f32)
    positions = jnp.broadcast_to(jnp.arange(SEQ, dtype=jnp.int32), (BATCH, SEQ))
    norm_gain = 1.0 + 0.02 * jax.random.normal(ks[1], (DEPTH, D_MODEL), f32)
    w_in = jax.random.normal(ks[2], (DEPTH, D_MODEL, IN_COLS), f32) * D_MODEL ** -0.5
    a_q_gain = 1.0 + 0.02 * jax.random.normal(ks[3], (DEPTH, HEAD_DIM), f32)
    a_k_gain = 1.0 + 0.02 * jax.random.normal(ks[4], (DEPTH, HEAD_DIM), f32)
    b_q_gain = 1.0 + 0.02 * jax.random.normal(ks[5], (DEPTH, HEAD_DIM), f32)
    b_k_gain = 1.0 + 0.02 * jax.random.normal(ks[6], (DEPTH, HEAD_DIM), f32)
    lambda_q1 = 0.1 * jax.random.normal(ks[7], (DEPTH, HEAD_DIM), f32)
    lambda_k1 = 0.1 * jax.random.normal(ks[8], (DEPTH, HEAD_DIM), f32)
    lambda_q2 = 0.1 * jax.random.normal(ks[9], (DEPTH, HEAD_DIM), f32)
    lambda_k2 = 0.1 * jax.random.normal(ks[10], (DEPTH, HEAD_DIM), f32)
    b_subln_gain = 1.0 + 0.02 * jax.random.normal(ks[11], (DEPTH, 2 * HEAD_DIM), f32)
    w_o_a = jax.random.normal(ks[12], (DEPTH, A_WIDTH, D_MODEL), f32) * A_WIDTH ** -0.5
    w_o_b = jax.random.normal(ks[13], (DEPTH, B_WIDTH, D_MODEL), f32) * B_WIDTH ** -0.5
    w_out = jax.random.normal(ks[14], (DEPTH, D_MODEL, D_MODEL), f32) * D_MODEL ** -0.5
    return {'x': x, 'positions': positions, 'norm_gain': norm_gain, 'w_in': w_in,
            'a_q_gain': a_q_gain, 'a_k_gain': a_k_gain, 'b_q_gain': b_q_gain, 'b_k_gain': b_k_gain,
            'lambda_q1': lambda_q1, 'lambda_k1': lambda_k1, 'lambda_q2': lambda_q2, 'lambda_k2': lambda_k2,
            'b_subln_gain': b_subln_gain, 'w_o_a': w_o_a, 'w_o_b': w_o_b, 'w_out': w_out}


def reference(x, positions, norm_gain, w_in, a_q_gain, a_k_gain, b_q_gain, b_k_gain,
              lambda_q1, lambda_k1, lambda_q2, lambda_k2, b_subln_gain, w_o_a, w_o_b, w_out):
    B, S, _ = x.shape
    nb = S // Q_BLOCK
    topk = min(TOPK_MAX, S // 4)
    offsets = np.cumsum(SPLIT_SIZES)[:-1].tolist()
    cos_h, sin_h = rope_tables(positions, HEAD_DIM)
    cos_i, sin_i = rope_tables(positions, IDX_DIM)
    key_idx = jnp.arange(S)
    q_idx_blocks = jnp.arange(S).reshape(nb, Q_BLOCK)

    def to_blocks(t):
        return jnp.swapaxes(t.reshape((B, nb, Q_BLOCK) + t.shape[2:]), 0, 1)

    def from_blocks(t):
        return jnp.swapaxes(t, 0, 1).reshape((B, S) + t.shape[3:])

    for l in range(DEPTH):
        h = rms_norm(x, norm_gain[l])
        proj = jnp.einsum('bsd,dn->bsn', h, w_in[l])
        (qa, ka, va, ga, qi, ki, wi, qb, kb, vb, gb, ma, mb) = jnp.split(proj, offsets, axis=-1)

        qa = apply_rope(rms_norm(qa.reshape(B, S, A_HEADS, HEAD_DIM), a_q_gain[l]), cos_h, sin_h)
        ka = apply_rope(rms_norm(ka.reshape(B, S, A_HEADS, HEAD_DIM), a_k_gain[l]), cos_h, sin_h)
        va = va.reshape(B, S, A_HEADS, HEAD_DIM)
        qi = apply_rope(qi.reshape(B, S, IDX_HEADS, IDX_DIM), cos_i, sin_i)
        ki = apply_rope(ki, cos_i, sin_i)
        wi = wi * (IDX_HEADS ** -0.5 * IDX_DIM ** -0.5)

        def a_block(args):
            qa_b, qi_b, wi_b, t_b = args
            rel = jax.nn.relu(jnp.einsum('bqhd,bsd->bqhs', qi_b, ki).astype(jnp.float32))
            score = jnp.einsum('bqhs,bqh->bqs', rel, wi_b.astype(jnp.float32))
            causal = key_idx[None, :] <= t_b[:, None]
            score = jnp.where(causal[None], score, -jnp.inf)
            _, sel = lax.top_k(score, topk)
            k_sel = jax.vmap(lambda kk, ii: kk[ii])(ka, sel)
            v_sel = jax.vmap(lambda vv, ii: vv[ii])(va, sel)
            s = jnp.einsum('bqhd,bqkhd->bqhk', qa_b, k_sel).astype(jnp.float32) * HEAD_DIM ** -0.5
            valid = (sel <= t_b[None, :, None])[:, :, None, :]
            p = jax.nn.softmax(jnp.where(valid, s, -jnp.inf), axis=-1)
            return jnp.einsum('bqhk,bqkhd->bqhd', p.astype(v_sel.dtype), v_sel)

        oa = lax.map(a_block, (to_blocks(qa), to_blocks(qi), to_blocks(wi), q_idx_blocks))
        oa = from_blocks(oa).reshape(B, S, A_WIDTH)

        lambda_init = 0.8 - 0.6 * math.exp(-0.3 * l)
        lam = (jnp.exp(jnp.sum(lambda_q1[l].astype(jnp.float32) * lambda_k1[l].astype(jnp.float32)))
               - jnp.exp(jnp.sum(lambda_q2[l].astype(jnp.float32) * lambda_k2[l].astype(jnp.float32)))
               + lambda_init)
        qb = apply_rope(rms_norm(qb.reshape(B, S, B_HEADS, 2, HEAD_DIM), b_q_gain[l]), cos_h, sin_h)
        kb = apply_rope(rms_norm(kb.reshape(B, S, B_HEADS, 2, HEAD_DIM), b_k_gain[l]), cos_h, sin_h)
        vb = vb.reshape(B, S, B_HEADS, 2 * HEAD_DIM)

        def b_block(args):
            q_b, t_b = args
            s = jnp.einsum('bqhcd,bshcd->bhcqs', q_b, kb).astype(jnp.float32) * HEAD_DIM ** -0.5
            causal = key_idx[None, :] <= t_b[:, None]
            p = jax.nn.softmax(jnp.where(causal[None, None, None], s, -jnp.inf), axis=-1)
            attn = p[:, :, 0] - lam * p[:, :, 1]
            return jnp.einsum('bhqs,bshe->bqhe', attn.astype(vb.dtype), vb)

        ob = from_blocks(lax.map(b_block, (to_blocks(qb), q_idx_blocks)))
        ob = (rms_norm(ob, b_subln_gain[l], SUBLN_EPS) * (1.0 - lambda_init)).reshape(B, S, B_WIDTH)

        ya = jnp.einsum('bsc,cd->bsd', oa * jax.nn.silu(ga), w_o_a[l])
        yb = jnp.einsum('bsc,cd->bsd', ob * jax.nn.silu(gb), w_o_b[l])
        merged = jax.nn.sigmoid(ma) * ya + jax.nn.sigmoid(mb) * yb
        x = x + jnp.einsum('bsd,de->bse', merged, w_out[l])
    return x
```

```cpp
#include <hip/hip_runtime.h>
#include <hip/hip_cooperative_groups.h>
#include <cstdio>
#include <cstdint>
namespace cg = cooperative_groups;

#define LAS __attribute__((address_space(3)))
#define GAS __attribute__((address_space(1)))
typedef unsigned short bf16_t;
typedef short bf16x8 __attribute__((ext_vector_type(8)));
typedef short s16x4 __attribute__((ext_vector_type(4)));
typedef float f32x4 __attribute__((ext_vector_type(4)));
typedef float f32x16 __attribute__((ext_vector_type(16)));
typedef unsigned u32x4 __attribute__((ext_vector_type(4)));
typedef unsigned u32x2 __attribute__((ext_vector_type(2)));
typedef unsigned long long u64;

constexpr int SEQ = 16384, NTOK = 32768, DM = 2048, INC = 13392, NP = 13568;
constexpr int LDS_BYTES = 131072 + 8192 + 64;
constexpr int ITEM_OFF = 131072 + 8192;
constexpr float QSCALE = 0.08838834764831845f * 1.4426950408889634f;

struct Params {
    const float* x; const int* pos; const float* norm_gain; const float* w_in;
    const float* a_q_gain; const float* a_k_gain; const float* b_q_gain; const float* b_k_gain;
    const float* lq1; const float* lk1; const float* lq2; const float* lk2; const float* subln;
    const float* w_o_a; const float* w_o_b; const float* w_out;
    float* out; unsigned char* ws;
};

typedef const __attribute__((address_space(4))) unsigned long long* KQ;
__device__ __forceinline__ Params load_params(KQ kq) {
    asm volatile("" : "+s"(kq));
    Params p;
    p.x = (const float*)kq[0]; p.pos = (const int*)kq[1]; p.norm_gain = (const float*)kq[2]; p.w_in = (const float*)kq[3];
    p.a_q_gain = (const float*)kq[4]; p.a_k_gain = (const float*)kq[5]; p.b_q_gain = (const float*)kq[6]; p.b_k_gain = (const float*)kq[7];
    p.lq1 = (const float*)kq[8]; p.lk1 = (const float*)kq[9]; p.lq2 = (const float*)kq[10]; p.lk2 = (const float*)kq[11]; p.subln = (const float*)kq[12];
    p.w_o_a = (const float*)kq[13]; p.w_o_b = (const float*)kq[14]; p.w_out = (const float*)kq[15];
    p.out = (float*)kq[16]; p.ws = (unsigned char*)kq[17];
    return p;
}

constexpr size_t MiB = 1u << 20;
constexpr size_t WS_CTR = 0;
constexpr size_t WS_WINT = 1 * MiB;
constexpr size_t WS_WOAT = 54 * MiB, WS_WOBT = 58 * MiB, WS_WOUTT = 62 * MiB;
constexpr size_t WS_QA = 70 * MiB, WS_KA = 134 * MiB, WS_VA = 198 * MiB, WS_SGA = 262 * MiB;
constexpr size_t WS_QI = 326 * MiB, WS_KI = 390 * MiB, WS_WI = 394 * MiB;
constexpr size_t WS_QB = 396 * MiB, WS_KB = 460 * MiB, WS_VB = 524 * MiB, WS_SGB = 588 * MiB;
constexpr size_t WS_SMA = 652 * MiB, WS_SMB = 780 * MiB;
constexpr size_t WS_UA = WS_QB, WS_UB = WS_KB;
constexpr size_t WS_MERGED = WS_QA;
constexpr size_t DO_H = 0, DO_OB = 0, DO_MASK = 128 * MiB, DO_COSA = 192 * MiB, DO_SINA = 200 * MiB, DO_COSI = 208 * MiB, DO_SINI = 212 * MiB;

__device__ __forceinline__ unsigned cvt_pk_bf16(float lo, float hi) { unsigned r; asm volatile("v_cvt_pk_bf16_f32 %0, %1, %2" : "=v"(r) : "v"(lo), "v"(hi)); return r; }
__device__ __forceinline__ float bf2f(unsigned short b) { return __uint_as_float(((unsigned)b) << 16); }
__device__ __forceinline__ float bflo(unsigned w) { return __uint_as_float(w << 16); }
__device__ __forceinline__ float bfhi(unsigned w) { return __uint_as_float(w & 0xffff0000u); }
__device__ __forceinline__ float fast_exp2(float x) { return __builtin_amdgcn_exp2f(x); }
__device__ __forceinline__ float sigmoidf_(float x) { return __builtin_amdgcn_rcpf(1.0f + __builtin_amdgcn_exp2f(-1.4426950408889634f * x)); }

__device__ __forceinline__ void lds_barrier() { asm volatile("s_waitcnt lgkmcnt(0)" ::: "memory"); __builtin_amdgcn_s_barrier(); asm volatile("" ::: "memory"); }
__device__ __forceinline__ int opaque_tid() { int t = threadIdx.x; asm volatile("" : "+v"(t)); return t; }

__device__ __forceinline__ int orig_col(int c) {
    if (c < 4096) { int seg = c >> 10, w = c & 1023; if (seg < 2) { int hd = w >> 7, p = w & 127; w = hd * 128 + (p & 1) * 64 + (p >> 1); } return seg * 1024 + w; }
    if (c < 5120) { int w = c - 4096; int hd = w >> 6, p = w & 63; return 4096 + hd * 64 + (p & 1) * 32 + (p >> 1); }
    if (c < 9216) { int w0 = c - 5120; int seg = w0 >> 10, w = w0 & 1023; if (seg < 2) { int hd = w >> 7, p = w & 127; w = hd * 128 + (p & 1) * 64 + (p >> 1); } return 5200 + seg * 1024 + w; }
    if (c < 13312) return 9296 + (c - 9216);
    int w = c - 13312;
    if (w < 64) return 5120 + (w & 1) * 32 + (w >> 1);
    if (w < 80) return 5184 + (w - 64);
    return -1;
}

template <bool MAPPED>
__device__ void transpose_convert(LAS unsigned char* lds, const float* src, int src_ld, int K, int ncols, bf16_t* dst, int dst_ld, int k_off, int tile0, int tstride) {
    LAS float* tile = (LAS float*)lds;
    const int tid = opaque_tid(), ktiles = K / 256, ntiles = (ncols / 64) * ktiles;
    for (int t = tile0; t < ntiles; t += tstride) {
        const int ct = t / ktiles, kt = t % ktiles, c0 = ct * 64, k0 = kt * 256;
        const int i = tid & 63, j = tid >> 6;
        const int oc = MAPPED ? orig_col(c0 + i) : (c0 + i);
        float v[32];
#pragma unroll
        for (int kk = 0; kk < 32; ++kk) v[kk] = (oc >= 0) ? __builtin_nontemporal_load((const GAS float*)(src + (size_t)(k0 + j + 8 * kk) * src_ld + oc)) : 0.f;
#pragma unroll
        for (int kk = 0; kk < 32; ++kk) tile[(j + 8 * kk) * 65 + i] = v[kk];
        __syncthreads();
#pragma unroll
        for (int u = 0; u < 4; ++u) {
            const int id = tid + 512 * u, q = ((id >> 8) << 2) | (id & 3), r = (id >> 2) & 63;
            u32x4 w;
            w.x = cvt_pk_bf16(tile[(q * 8 + 0) * 65 + r], tile[(q * 8 + 1) * 65 + r]); w.y = cvt_pk_bf16(tile[(q * 8 + 2) * 65 + r], tile[(q * 8 + 3) * 65 + r]);
            w.z = cvt_pk_bf16(tile[(q * 8 + 4) * 65 + r], tile[(q * 8 + 5) * 65 + r]); w.w = cvt_pk_bf16(tile[(q * 8 + 6) * 65 + r], tile[(q * 8 + 7) * 65 + r]);
            *(GAS u32x4*)(dst + (size_t)(c0 + r) * dst_ld + k_off + k0 + q * 8) = w;
        }
        __syncthreads();
    }
}

__device__ void prep_phase(const Params& p, LAS unsigned char* lds) {
    const int tid = opaque_tid(), wid = tid >> 6, lane = tid & 63;
    unsigned char* dout = (unsigned char*)p.out;
    {
        bf16_t* H = (bf16_t*)(dout + DO_H);
        const int gw = blockIdx.x * 8 + wid, nw = gridDim.x * 8;
        for (int n0 = gw; n0 < NTOK; n0 += 2 * nw) {
            const int n1 = n0 + nw;
            const float* xr0 = p.x + (size_t)n0 * DM; const float* xr1 = p.x + (size_t)n1 * DM;
            f32x4 v0[8], v1[8]; float s0 = 0.f, s1 = 0.f;
#pragma unroll
            for (int i = 0; i < 8; ++i) { v0[i] = __builtin_nontemporal_load((const GAS f32x4*)(xr0 + i * 256 + lane * 4)); v1[i] = __builtin_nontemporal_load((const GAS f32x4*)(xr1 + i * 256 + lane * 4)); }
#pragma unroll
            for (int i = 0; i < 8; ++i) { s0 += v0[i][0] * v0[i][0] + v0[i][1] * v0[i][1] + v0[i][2] * v0[i][2] + v0[i][3] * v0[i][3];
                                          s1 += v1[i][0] * v1[i][0] + v1[i][1] * v1[i][1] + v1[i][2] * v1[i][2] + v1[i][3] * v1[i][3]; }
#pragma unroll
            for (int o = 32; o >= 1; o >>= 1) { s0 += __shfl_xor(s0, o); s1 += __shfl_xor(s1, o); }
            const float r0 = rsqrtf(s0 * (1.0f / DM) + 1e-6f), r1 = rsqrtf(s1 * (1.0f / DM) + 1e-6f);
#pragma unroll
            for (int i = 0; i < 8; ++i) { const f32x4 g = *(const GAS f32x4*)(p.norm_gain + i * 256 + lane * 4);
                u32x2 w; w.x = cvt_pk_bf16(v0[i][0] * r0 * g[0], v0[i][1] * r0 * g[1]); w.y = cvt_pk_bf16(v0[i][2] * r0 * g[2], v0[i][3] * r0 * g[3]);
                *(GAS u32x2*)(H + (size_t)n0 * DM + i * 256 + lane * 4) = w;
                u32x2 w2; w2.x = cvt_pk_bf16(v1[i][0] * r1 * g[0], v1[i][1] * r1 * g[1]); w2.y = cvt_pk_bf16(v1[i][2] * r1 * g[2], v1[i][3] * r1 * g[3]);
                *(GAS u32x2*)(H + (size_t)n1 * DM + i * 256 + lane * 4) = w2; }
        }
    }
    {
        float* cosA = (float*)(dout + DO_COSA); float* sinA = (float*)(dout + DO_SINA); float* cosI = (float*)(dout + DO_COSI); float* sinI = (float*)(dout + DO_SINI);
        LAS float* invf = (LAS float*)(lds + 32768);
        if (tid < 64) invf[tid] = (float)pow(10000.0, -(double)(2 * tid) / 128.0);
        else if (tid < 96) invf[tid] = (float)pow(10000.0, -(double)(2 * (tid - 64)) / 64.0);
        __syncthreads();
        const int gt = blockIdx.x * 512 + tid, nthr = gridDim.x * 512;
        for (int e = gt; e < NTOK * 96; e += nthr) {
            const int n = e / 96, i = e % 96;
            const float a = (float)p.pos[n] * invf[i];
            float sv, cv; sincosf(a, &sv, &cv);
            if (i < 64) { cosA[(size_t)n * 64 + i] = cv; sinA[(size_t)n * 64 + i] = sv; }
            else { cosI[(size_t)n * 32 + (i - 64)] = cv; sinI[(size_t)n * 32 + (i - 64)] = sv; }
        }
        __syncthreads();
    }
    transpose_convert<true>(lds, p.w_in, INC, DM, NP, (bf16_t*)(p.ws + WS_WINT), DM, 0, blockIdx.x, gridDim.x);
    transpose_convert<false>(lds, p.w_o_a, DM, 1024, DM, (bf16_t*)(p.ws + WS_WOAT), DM, 0, blockIdx.x, gridDim.x);
    transpose_convert<false>(lds, p.w_o_b, DM, 1024, DM, (bf16_t*)(p.ws + WS_WOAT), DM, 1024, blockIdx.x, gridDim.x);
    transpose_convert<false>(lds, p.w_out, DM, DM, DM, (bf16_t*)(p.ws + WS_WOUTT), DM, 0, blockIdx.x, gridDim.x);
}

namespace pg8 {
constexpr int BM = 256, BK = 64, HALF = 128, HTB = HALF * BK * 2, STAGE_BYTES = 8 * HTB, NXCD = 8, WGM = 16;
__device__ __forceinline__ int lds_byte(int r, int c) { const int st = (r >> 4) * 2 + (c >> 5), rr = r & 15, cc = c & 31, ob = rr * 64 + cc * 2; return st * 1024 + (ob ^ (((ob >> 9) & 1) << 5)); }
__device__ __forceinline__ void stage_rc(int b, int& R, int& C) { const int st = b / 1024, sb = b % 1024, swz = sb ^ (((sb >> 9) & 1) << 5); R = (st >> 1) * 16 + swz / 64; C = (st & 1) * 32 + (swz % 64) / 2; }
__device__ __forceinline__ int perm32(int rho) { const int n = rho >> 4, i = rho & 15; return 8 * (i >> 2) + 4 * n + (i & 3); }
struct Unit { int pm, pn; };
struct Gemm { const bf16_t* A; const bf16_t* Bt; int M, N, K; };
struct StaticOrder {
    int nM, nN, nwg, G, c;
    __device__ void init(int M, int N, int G_, int c_) { nM = M / BM; nN = N / BM; nwg = nM * nN; G = G_; c = c_; }
    __device__ bool next(int i, Unit& u) const {
        const long L = (long)i * G + c; if (L >= nwg) return false;
        int wgid = (int)L; { const int q = nwg / NXCD, r = nwg % NXCD, xcd = wgid % NXCD, off = wgid / NXCD; wgid = (xcd < r ? xcd * (q + 1) : r * (q + 1) + (xcd - r) * q) + off; }
        const int nig = WGM * nN, gid = wgid / nig, fm = gid * WGM, gsz = (nM - fm) < WGM ? (nM - fm) : WGM;
        u.pm = fm + ((wgid % nig) % gsz); u.pn = (wgid % nig) / gsz; return true;
    }
};

template <class Epi>
__device__ __forceinline__ void gemm_phase(LAS unsigned char* lds, const Gemm g, const StaticOrder& S, const Epi& E) {
    const int tid = opaque_tid(), wid = __builtin_amdgcn_readfirstlane(tid >> 6), lane = tid & 63, wr = wid >> 2, wc = wid & 3, fr = lane & 15, fq = lane >> 4;
    const int K = g.K, nt = K / BK;
    unsigned voffA[2], voffB[2];
#pragma unroll
    for (int i = 0; i < 2; ++i) { int R, C; stage_rc(tid * 16 + i * 8192, R, C); const int Rb = (R & ~31) + perm32(R & 31);
        voffA[i] = (unsigned)(R * K + C) * 2u; voffB[i] = (unsigned)(Rb * K + C) * 2u; }
    const size_t kstep = (size_t)(BK * 2);
    const size_t hstep = (size_t)HALF * K * 2;
    const size_t tstep = 2 * hstep;
    const unsigned ldsw = (unsigned)wid * 1024u;
    const int aoff = lds_byte(wr * 64 + fr, fq * 8), boff = lds_byte(wc * 32 + fr, fq * 8);
#define PG8_SA(b, h) (((b) * 2 + (h)) * HTB)
#define PG8_SB(b, h) ((4 + (b) * 2 + (h)) * HTB)
#define PG8_STAGE(bufoff, gbase, voff) do { _Pragma("unroll") for (int _i = 0; _i < 2; ++_i) \
        __builtin_amdgcn_global_load_lds((const unsigned*)((const char*)(gbase) + (voff)[_i]), (LAS unsigned*)(lds + (bufoff) + ldsw + _i * 8192), 16, 0, 0); } while (0)
#define PG8_LDA(dst, b, h) do { _Pragma("unroll") for (int m = 0; m < 4; ++m) _Pragma("unroll") for (int k = 0; k < 2; ++k) dst[m][k] = *(const LAS bf16x8*)(lds + PG8_SA(b, h) + aoff + m * 2048 + k * 1024); } while (0)
#define PG8_LDB(dst, b, h) do { _Pragma("unroll") for (int n = 0; n < 2; ++n) _Pragma("unroll") for (int k = 0; k < 2; ++k) dst[n][k] = *(const LAS bf16x8*)(lds + PG8_SB(b, h) + boff + n * 2048 + k * 1024); } while (0)
#define PG8_MMA(ai, bj, At, Bt) do { __builtin_amdgcn_s_setprio(1); _Pragma("unroll") for (int m = 0; m < 4; ++m) _Pragma("unroll") for (int n = 0; n < 2; ++n) _Pragma("unroll") for (int k = 0; k < 2; ++k) \
        acc[ai][bj][m][n] = __builtin_amdgcn_mfma_f32_16x16x32_bf16(Bt[n][k], At[m][k], acc[ai][bj][m][n], 0, 0, 0); __builtin_amdgcn_s_setprio(0); } while (0)
#define PG8_WAIT_V(n) asm volatile("s_waitcnt vmcnt(" #n ")" ::: "memory")
#define PG8_WAIT_L(n) asm volatile("s_waitcnt lgkmcnt(" #n ")" ::: "memory")
#define PG8_BAR __builtin_amdgcn_s_barrier()
#define PG8_SCHED __builtin_amdgcn_sched_barrier(0)
    Unit cur, nxt; int ui = 0;
    if (!S.next(0, cur)) return;
    f32x4 acc[2][2][4][2];
#pragma unroll
    for (int a = 0; a < 2; ++a)
#pragma unroll
        for (int b = 0; b < 2; ++b)
#pragma unroll
            for (int m = 0; m < 4; ++m)
#pragma unroll
                for (int n = 0; n < 2; ++n) acc[a][b][m][n] = (f32x4){0.f, 0.f, 0.f, 0.f};
    bf16x8 At[4][2], B0[2][2], B1[2][2];
    const char* cA = (const char*)g.A + (size_t)cur.pm * tstep; const char* cB = (const char*)g.Bt + (size_t)cur.pn * tstep;
    PG8_STAGE(PG8_SB(0, 0), cB, voffB); PG8_STAGE(PG8_SA(0, 0), cA, voffA); PG8_STAGE(PG8_SB(0, 1), cB + hstep, voffB); PG8_STAGE(PG8_SA(0, 1), cA + hstep, voffA);
    if (wr == 1) PG8_BAR;
    PG8_WAIT_V(4); PG8_BAR;
    PG8_STAGE(PG8_SB(1, 0), cB + kstep, voffB); PG8_STAGE(PG8_SA(1, 0), cA + kstep, voffA); PG8_STAGE(PG8_SB(1, 1), cB + hstep + kstep, voffB);
    PG8_WAIT_V(6); PG8_BAR;
    for (;;) {
        const bool has_next = S.next(ui + 1, nxt);
        const char* nA = has_next ? (const char*)g.A + (size_t)nxt.pm * tstep : cA; const char* nB = has_next ? (const char*)g.Bt + (size_t)nxt.pn * tstep : cB;
        for (int t = 0; t < nt; t += 2) {
            if (Epi::MID_T >= 0 && t == Epi::MID_T) E.mid(acc, cur, wr, wc, fr, fq);
            const bool last = (t == nt - 2);
            const char* a1 = cA + (size_t)(t + 1) * kstep;
            const char* a2 = last ? nA : cA + (size_t)(t + 2) * kstep; const char* b2 = last ? nB : cB + (size_t)(t + 2) * kstep;
            const char* a3 = a2 + kstep; const char* b3 = b2 + kstep;
            PG8_LDB(B0, 0, 0); PG8_SCHED; PG8_LDA(At, 0, 0); PG8_STAGE(PG8_SA(1, 1), a1 + hstep, voffA);
            PG8_WAIT_L(8); PG8_BAR; PG8_WAIT_L(0); PG8_MMA(0, 0, At, B0); PG8_BAR; PG8_SCHED;
            PG8_LDB(B1, 0, 1); PG8_STAGE(PG8_SB(0, 0), b2, voffB);
            PG8_BAR; PG8_WAIT_L(0); PG8_MMA(0, 1, At, B1); PG8_BAR;
            PG8_LDA(At, 0, 1); PG8_STAGE(PG8_SA(0, 0), a2, voffA);
            PG8_BAR; PG8_WAIT_L(0); PG8_MMA(1, 0, At, B0); PG8_BAR; PG8_SCHED;
            PG8_STAGE(PG8_SB(0, 1), b2 + hstep, voffB);
            PG8_WAIT_V(6); PG8_BAR; PG8_MMA(1, 1, At, B1); PG8_BAR;
            PG8_LDB(B0, 1, 0); PG8_SCHED; PG8_LDA(At, 1, 0); PG8_STAGE(PG8_SA(0, 1), a2 + hstep, voffA);
            PG8_WAIT_L(8); PG8_BAR; PG8_WAIT_L(0); PG8_MMA(0, 0, At, B0); PG8_BAR; PG8_SCHED;
            PG8_LDB(B1, 1, 1); PG8_STAGE(PG8_SB(1, 0), b3, voffB);
            PG8_BAR; PG8_WAIT_L(0); PG8_MMA(0, 1, At, B1); PG8_BAR;
            PG8_LDA(At, 1, 1); PG8_STAGE(PG8_SA(1, 0), a3, voffA);
            PG8_BAR; PG8_WAIT_L(0); PG8_MMA(1, 0, At, B0); PG8_BAR; PG8_SCHED;
            PG8_STAGE(PG8_SB(1, 1), b3 + hstep, voffB);
            PG8_WAIT_V(6); PG8_BAR; PG8_MMA(1, 1, At, B1); PG8_BAR;
        }
        E(acc, cur, wr, wc, fr, fq);
        if (!has_next) break;
#pragma unroll
        for (int a = 0; a < 2; ++a)
#pragma unroll
            for (int b = 0; b < 2; ++b)
#pragma unroll
                for (int m = 0; m < 4; ++m)
#pragma unroll
                    for (int n = 0; n < 2; ++n) acc[a][b][m][n] = (f32x4){0.f, 0.f, 0.f, 0.f};
        cur = nxt; cA = nA; cB = nB; ++ui;
    }
    PG8_WAIT_V(0);
    if (wr == 0) PG8_BAR;
    PG8_BAR;
#undef PG8_SA
#undef PG8_SB
#undef PG8_STAGE
#undef PG8_LDA
#undef PG8_LDB
#undef PG8_MMA
#undef PG8_WAIT_V
#undef PG8_WAIT_L
#undef PG8_SCHED
}
}

struct EpiIn {
    static constexpr int MID_T = -1;
    __device__ __forceinline__ void mid(f32x4 (&)[2][2][4][2], const pg8::Unit&, int, int, int, int) const {}
    unsigned char* ws; const float* cosA; const float* sinA; const float* cosI; const float* sinI;
    const float* gaq; const float* gak; const float* gbq; const float* gbk;
    LAS float* red;
    __device__ __forceinline__ void operator()(const f32x4 (&acc)[2][2][4][2], const pg8::Unit& u, int wr, int wc, int fr_in, int fq_in) const {
        int fr = fr_in, fq = fq_in; asm volatile("" : "+v"(fr), "+v"(fq));
        const int pn = u.pn;
        const int row0 = u.pm * 256 + wr * 64 + fr;
        const int cw = wc * 32 + fq * 8;
        int mode; bf16_t* dst; int ldc = 1024, colbase; const float* gain = nullptr; float qs = 1.f;
        if (pn < 16) { const int seg = pn >> 2; colbase = (pn & 3) * 256;
            dst = (bf16_t*)(ws + (seg == 0 ? WS_QA : seg == 1 ? WS_KA : seg == 2 ? WS_VA : WS_SGA));
            mode = seg < 2 ? 4 : (seg == 2 ? 0 : 1); gain = seg == 0 ? gaq : gak; qs = seg == 0 ? QSCALE : 1.f; }
        else if (pn < 20) { colbase = (pn - 16) * 256; dst = (bf16_t*)(ws + WS_QI); mode = 3; }
        else if (pn < 36) { const int seg = (pn - 20) >> 2; colbase = ((pn - 20) & 3) * 256;
            dst = (bf16_t*)(ws + (seg == 0 ? WS_QB : seg == 1 ? WS_KB : seg == 2 ? WS_VB : WS_SGB));
            mode = seg < 2 ? 4 : (seg == 2 ? 0 : 1); gain = seg == 0 ? gbq : gbk; qs = seg == 0 ? QSCALE : 1.f; }
        else if (pn < 44) { colbase = (pn - 36) * 256; dst = (bf16_t*)(ws + WS_SMA); ldc = 2048; mode = 2; }
        else if (pn < 52) { colbase = (pn - 44) * 256; dst = (bf16_t*)(ws + WS_SMB); ldc = 2048; mode = 2; }
        else { colbase = 0; dst = (bf16_t*)(ws + WS_KI); ldc = 64; mode = 5; }

        if (mode == 4) {
            LAS float* redw = red + ((wr * 64 + fr) * 2) * 4 + wc;
            const LAS float* redr = red + ((wr * 64 + fr) * 2) * 4;
#pragma unroll
            for (int ai = 0; ai < 2; ++ai)
#pragma unroll
                for (int m = 0; m < 4; ++m)
#pragma unroll
                    for (int bj = 0; bj < 2; ++bj) {
                        const f32x4 a = acc[ai][bj][m][0], b = acc[ai][bj][m][1];
                        float ss = a[0] * a[0] + a[1] * a[1] + a[2] * a[2] + a[3] * a[3] + b[0] * b[0] + b[1] * b[1] + b[2] * b[2] + b[3] * b[3];
                        ss += __shfl_xor(ss, 16); ss += __shfl_xor(ss, 32);
                        if (fq == 0) redw[((ai * 128 + m * 16) * 2 + bj) * 4] = ss;
                        __builtin_amdgcn_sched_barrier(0);
                    }
            asm volatile("s_waitcnt lgkmcnt(0)" ::: "memory");
            __builtin_amdgcn_s_barrier();
            const int pi0 = cw >> 1;
            const f32x4 g1 = *(const GAS f32x4*)(gain + pi0), g2 = *(const GAS f32x4*)(gain + 64 + pi0);
#pragma unroll
            for (int ai = 0; ai < 2; ++ai)
#pragma unroll
                for (int m = 0; m < 4; ++m) {
                    const int rl = ai * 128 + wr * 64 + m * 16 + fr; const int row = u.pm * 256 + rl;
                    const f32x4 cs = *(const GAS f32x4*)(cosA + (size_t)row * 64 + pi0), sn = *(const GAS f32x4*)(sinA + (size_t)row * 64 + pi0);
#pragma unroll
                    for (int bj = 0; bj < 2; ++bj) {
                        const f32x4 r4 = *(const LAS f32x4*)(redr + ((ai * 128 + m * 16) * 2 + bj) * 4);
                        const float inv = rsqrtf((r4[0] + r4[1] + r4[2] + r4[3]) * (1.0f / 128.f) + 1e-6f) * qs;
                        const f32x4 a = acc[ai][bj][m][0], b = acc[ai][bj][m][1];
                        const float x1a = a[0] * inv * g1[0], x2a = a[1] * inv * g2[0], x1b = a[2] * inv * g1[1], x2b = a[3] * inv * g2[1];
                        const float x1c = b[0] * inv * g1[2], x2c = b[1] * inv * g2[2], x1d = b[2] * inv * g1[3], x2d = b[3] * inv * g2[3];
                        u32x4 w;
                        w.x = cvt_pk_bf16(x1a * cs[0] - x2a * sn[0], x2a * cs[0] + x1a * sn[0]);
                        w.y = cvt_pk_bf16(x1b * cs[1] - x2b * sn[1], x2b * cs[1] + x1b * sn[1]);
                        w.z = cvt_pk_bf16(x1c * cs[2] - x2c * sn[2], x2c * cs[2] + x1c * sn[2]);
                        w.w = cvt_pk_bf16(x1d * cs[3] - x2d * sn[3], x2d * cs[3] + x1d * sn[3]);
                        __builtin_nontemporal_store(w, (GAS u32x4*)(dst + (size_t)row * ldc + colbase + bj * 128 + cw));
                    }
                    __builtin_amdgcn_sched_barrier(0);
                }
            return;
        }
        if (mode == 3 || mode == 5) {
            const int pi0 = (cw & 63) >> 1;
#pragma unroll
            for (int ai = 0; ai < 2; ++ai)
#pragma unroll
                for (int m = 0; m < 4; ++m) {
                    const int row = row0 + ai * 128 + m * 16;
                    const f32x4 cs = *(const GAS f32x4*)(cosI + (size_t)row * 32 + pi0), sn = *(const GAS f32x4*)(sinI + (size_t)row * 32 + pi0);
#pragma unroll
                    for (int bj = 0; bj < 2; ++bj) {
                        const f32x4 a = acc[ai][bj][m][0], b = acc[ai][bj][m][1];
                        if (mode == 5) {
                            if (bj == 1 || wc == 3) continue;
                            if (wc == 2) { if (fq < 2) { float* wi = (float*)(ws + WS_WI) + (size_t)row * 16 + fq * 8;
                                    *(GAS f32x4*)wi = a * 0.03125f; *(GAS f32x4*)(wi + 4) = b * 0.03125f; }
                                continue; }
                        }
                        u32x4 w;
                        w.x = cvt_pk_bf16(a[0] * cs[0] - a[1] * sn[0], a[1] * cs[0] + a[0] * sn[0]);
                        w.y = cvt_pk_bf16(a[2] * cs[1] - a[3] * sn[1], a[3] * cs[1] + a[2] * sn[1]);
                        w.z = cvt_pk_bf16(b[0] * cs[2] - b[1] * sn[2], b[1] * cs[2] + b[0] * sn[2]);
                        w.w = cvt_pk_bf16(b[2] * cs[3] - b[3] * sn[3], b[3] * cs[3] + b[2] * sn[3]);
                        __builtin_nontemporal_store(w, (GAS u32x4*)(dst + (size_t)row * ldc + colbase + bj * 128 + cw));
                    }
                    __builtin_amdgcn_sched_barrier(0);
                }
            return;
        }
#pragma unroll
        for (int ai = 0; ai < 2; ++ai)
#pragma unroll
            for (int m = 0; m < 4; ++m) {
                const int row = row0 + ai * 128 + m * 16;
#pragma unroll
                for (int bj = 0; bj < 2; ++bj) {
                    f32x4 a = acc[ai][bj][m][0], b = acc[ai][bj][m][1];
                    if (mode == 1) {
#pragma unroll
                        for (int j = 0; j < 4; ++j) { a[j] = a[j] * sigmoidf_(a[j]); b[j] = b[j] * sigmoidf_(b[j]); } }
                    else if (mode == 2) {
#pragma unroll
                        for (int j = 0; j < 4; ++j) { a[j] = sigmoidf_(a[j]); b[j] = sigmoidf_(b[j]); } }
                    u32x4 w; w.x = cvt_pk_bf16(a[0], a[1]); w.y = cvt_pk_bf16(a[2], a[3]); w.z = cvt_pk_bf16(b[0], b[1]); w.w = cvt_pk_bf16(b[2], b[3]);
                    __builtin_nontemporal_store(w, (GAS u32x4*)(dst + (size_t)row * ldc + colbase + bj * 128 + cw));
                }
                __builtin_amdgcn_sched_barrier(0);
            }
    }
};

template <int MODE> struct EpiOut {
    static constexpr int MID_T = -1;
    __device__ __forceinline__ void mid(f32x4 (&)[2][2][4][2], const pg8::Unit&, int, int, int, int) const {}
    const bf16_t* gate; float* tmp; bf16_t* merged; const float* x; float* out;
    __device__ __forceinline__ void operator()(const f32x4 (&acc)[2][2][4][2], const pg8::Unit& u, int wr, int wc, int fr_in, int fq_in) const {
        int fr = fr_in, fq = fq_in; asm volatile("" : "+v"(fr), "+v"(fq));
        const int row0 = u.pm * 256 + wr * 64 + fr, col0 = u.pn * 256 + wc * 32 + fq * 8;
        if (MODE == 2) {
            f32x4 xb[4][4];
#define EO_LOAD(it) do { const size_t _ro = (size_t)(row0 + ((it) >> 2) * 128 + ((it) & 3) * 16) * DM + col0; \
                xb[(it) & 3][0] = __builtin_nontemporal_load((const GAS f32x4*)(x + _ro)); xb[(it) & 3][1] = __builtin_nontemporal_load((const GAS f32x4*)(x + _ro + 4)); \
                xb[(it) & 3][2] = __builtin_nontemporal_load((const GAS f32x4*)(x + _ro + 128)); xb[(it) & 3][3] = __builtin_nontemporal_load((const GAS f32x4*)(x + _ro + 132)); } while (0)
            EO_LOAD(0); EO_LOAD(1); EO_LOAD(2);
#pragma unroll
            for (int it = 0; it < 8; ++it) {
                if (it + 3 < 8) EO_LOAD(it + 3);
                const int ai = it >> 2, m = it & 3;
                const size_t ro = (size_t)(row0 + ai * 128 + m * 16) * DM + col0;
                __builtin_nontemporal_store(xb[it & 3][0] + acc[ai][0][m][0], (GAS f32x4*)(out + ro)); __builtin_nontemporal_store(xb[it & 3][1] + acc[ai][0][m][1], (GAS f32x4*)(out + ro + 4));
                __builtin_nontemporal_store(xb[it & 3][2] + acc[ai][1][m][0], (GAS f32x4*)(out + ro + 128)); __builtin_nontemporal_store(xb[it & 3][3] + acc[ai][1][m][1], (GAS f32x4*)(out + ro + 132));
                __builtin_amdgcn_sched_barrier(0);
            }
#undef EO_LOAD
            return;
        }
#pragma unroll
        for (int ai = 0; ai < 2; ++ai)
#pragma unroll
            for (int m = 0; m < 4; ++m) {
                const size_t ro = (size_t)(row0 + ai * 128 + m * 16) * DM + col0;
#pragma unroll
                for (int bj = 0; bj < 2; ++bj) {
                    const size_t o = ro + bj * 128;
                    f32x4 a = acc[ai][bj][m][0], b = acc[ai][bj][m][1];
                    if (MODE == 2) {
                        const f32x4 xa = *(const GAS f32x4*)(x + o), xb = *(const GAS f32x4*)(x + o + 4);
                        *(GAS f32x4*)(out + o) = xa + a; *(GAS f32x4*)(out + o + 4) = xb + b;
                    } else {
                        const u32x4 gw = *(const GAS u32x4*)(gate + o);
                        a[0] *= bflo(gw.x); a[1] *= bfhi(gw.x); a[2] *= bflo(gw.y); a[3] *= bfhi(gw.y);
                        b[0] *= bflo(gw.z); b[1] *= bfhi(gw.z); b[2] *= bflo(gw.w); b[3] *= bfhi(gw.w);
                        if (MODE == 0) { *(GAS f32x4*)(tmp + o) = a; *(GAS f32x4*)(tmp + o + 4) = b; }
                        else { const f32x4 ta = *(const GAS f32x4*)(tmp + o), tb = *(const GAS f32x4*)(tmp + o + 4); a += ta; b += tb;
                            u32x4 w; w.x = cvt_pk_bf16(a[0], a[1]); w.y = cvt_pk_bf16(a[2], a[3]); w.z = cvt_pk_bf16(b[0], b[1]); w.w = cvt_pk_bf16(b[2], b[3]);
                            *(GAS u32x4*)(merged + o) = w; }
                    }
                }
                __builtin_amdgcn_sched_barrier(0);
            }
    }
};

struct EpiMerge {
    static constexpr int MID_T = 16;
    const bf16_t* ga; const bf16_t* gb; bf16_t* merged;
    __device__ __forceinline__ void mid(f32x4 (&acc)[2][2][4][2], const pg8::Unit& u, int wr, int wc, int fr_in, int fq_in) const {
        int fr = fr_in, fq = fq_in; asm volatile("" : "+v"(fr), "+v"(fq));
        const int row0 = u.pm * 256 + wr * 64 + fr, col0 = u.pn * 256 + wc * 32 + fq * 8;
        u32x4 ab[4][2], bb[4][2];
#define EM_LOAD(it) do { const size_t _ro = (size_t)(row0 + ((it) >> 2) * 128 + ((it) & 3) * 16) * DM + col0; \
            ab[(it) & 3][0] = *(const GAS u32x4*)(ga + _ro); ab[(it) & 3][1] = *(const GAS u32x4*)(ga + _ro + 128); \
            bb[(it) & 3][0] = *(const GAS u32x4*)(gb + _ro); bb[(it) & 3][1] = *(const GAS u32x4*)(gb + _ro + 128); } while (0)
        EM_LOAD(0); EM_LOAD(1); EM_LOAD(2);
#pragma unroll
        for (int it = 0; it < 8; ++it) {
            if (it + 3 < 8) EM_LOAD(it + 3);
            const int ai = it >> 2, m = it & 3;
#pragma unroll
            for (int bj = 0; bj < 2; ++bj) {
                const u32x4 a = ab[it & 3][bj], b = bb[it & 3][bj];
                f32x4& x = acc[ai][bj][m][0]; f32x4& y = acc[ai][bj][m][1];
                x[0] *= bflo(a.x) * __builtin_amdgcn_rcpf(fmaxf(bflo(b.x), 1e-30f)); x[1] *= bfhi(a.x) * __builtin_amdgcn_rcpf(fmaxf(bfhi(b.x), 1e-30f));
                x[2] *= bflo(a.y) * __builtin_amdgcn_rcpf(fmaxf(bflo(b.y), 1e-30f)); x[3] *= bfhi(a.y) * __builtin_amdgcn_rcpf(fmaxf(bfhi(b.y), 1e-30f));
                y[0] *= bflo(a.z) * __builtin_amdgcn_rcpf(fmaxf(bflo(b.z), 1e-30f)); y[1] *= bfhi(a.z) * __builtin_amdgcn_rcpf(fmaxf(bfhi(b.z), 1e-30f));
                y[2] *= bflo(a.w) * __builtin_amdgcn_rcpf(fmaxf(bflo(b.w), 1e-30f)); y[3] *= bfhi(a.w) * __builtin_amdgcn_rcpf(fmaxf(bfhi(b.w), 1e-30f));
            }
            __builtin_amdgcn_sched_barrier(0);
        }
#undef EM_LOAD
    }
    __device__ __forceinline__ void operator()(const f32x4 (&acc)[2][2][4][2], const pg8::Unit& u, int wr, int wc, int fr_in, int fq_in) const {
        int fr = fr_in, fq = fq_in; asm volatile("" : "+v"(fr), "+v"(fq));
        const int row0 = u.pm * 256 + wr * 64 + fr, col0 = u.pn * 256 + wc * 32 + fq * 8;
        u32x4 bb[4][2];
#define EM_LOAD(it) do { const size_t _ro = (size_t)(row0 + ((it) >> 2) * 128 + ((it) & 3) * 16) * DM + col0; \
            bb[(it) & 3][0] = *(const GAS u32x4*)(gb + _ro); bb[(it) & 3][1] = *(const GAS u32x4*)(gb + _ro + 128); } while (0)
        EM_LOAD(0); EM_LOAD(1); EM_LOAD(2);
#pragma unroll
        for (int it = 0; it < 8; ++it) {
            if (it + 3 < 8) EM_LOAD(it + 3);
            const int ai = it >> 2, m = it & 3;
            const size_t ro = (size_t)(row0 + ai * 128 + m * 16) * DM + col0;
#pragma unroll
            for (int bj = 0; bj < 2; ++bj) {
                const u32x4 b = bb[it & 3][bj];
                const f32x4 x = acc[ai][bj][m][0], y = acc[ai][bj][m][1];
                u32x4 w; w.x = cvt_pk_bf16(x[0] * bflo(b.x), x[1] * bfhi(b.x)); w.y = cvt_pk_bf16(x[2] * bflo(b.y), x[3] * bfhi(b.y));
                w.z = cvt_pk_bf16(y[0] * bflo(b.z), y[1] * bfhi(b.z)); w.w = cvt_pk_bf16(y[2] * bflo(b.w), y[3] * bfhi(b.w));
                *(GAS u32x4*)(merged + ro + bj * 128) = w;
            }
            __builtin_amdgcn_sched_barrier(0);
        }
#undef EM_LOAD
    }
};

__device__ __forceinline__ float score_bound_neg(const float* gq, const float* gk, int lane) {
    float a = fmaxf(fabsf(gq[lane]), fabsf(gq[lane + 64])), b = fmaxf(fabsf(gk[lane]), fabsf(gk[lane + 64]));
#pragma unroll
    for (int off = 32; off >= 1; off >>= 1) { a = fmaxf(a, __shfl_xor(a, off)); b = fmaxf(b, __shfl_xor(b, off)); }
    return -(128.0f * QSCALE * 1.02f) * a * b;
}
constexpr int KP = 272, VP = 320, KBYTES = 64 * KP, VBYTES = 64 * VP, ASTAGE = KBYTES + VBYTES;

template <int MODE>
__device__ void attn_block(LAS unsigned char* lds, const bf16_t* Qp, const bf16_t* Kp, const bf16_t* Vp, int qb, const unsigned* maskp, const bf16_t* sga, bf16_t* outp, const float negMB) {
    const int tid = opaque_tid(), wid = __builtin_amdgcn_readfirstlane(tid >> 6), lane = tid & 63, c = lane & 31, h = lane >> 5;
    const int grp = wid >> 2;
    const int q0 = qb * 256 + wid * 32, qpos = q0 + c;
    bf16x8 qf[8];
#pragma unroll
    for (int ks = 0; ks < 8; ++ks) qf[ks] = *(const GAS bf16x8*)(Qp + (size_t)qpos * 1024 + ks * 16 + h * 8);
    f32x16 o[4];
#pragma unroll
    for (int d = 0; d < 4; ++d)
#pragma unroll
        for (int r = 0; r < 16; ++r) o[d][r] = 0.f;
    float lrun = 0.f;
    const int nt = 4 * (qb + 1);
    const int my_last = (q0 + 31) >> 6;
    const int srow = tid >> 4, sch = tid & 15;
    u32x4 kr[2], vr[2];
    bf16x8 pf[2][2];
#pragma unroll
    for (int a = 0; a < 2; ++a)
#pragma unroll
        for (int b = 0; b < 2; ++b) pf[a][b] = (bf16x8){0, 0, 0, 0, 0, 0, 0, 0};
#define ATT_GLOAD(j) do { _Pragma("unroll") for (int _i = 0; _i < 2; ++_i) { const size_t _o = (size_t)((j) * 64 + srow + 32 * _i) * 1024 + sch * 8; \
        kr[_i] = *(const GAS u32x4*)(Kp + _o); vr[_i] = *(const GAS u32x4*)(Vp + _o); } } while (0)
#define ATT_LSTORE(buf) do { _Pragma("unroll") for (int _i = 0; _i < 2; ++_i) { \
        *(LAS u32x4*)(lds + (buf) * ASTAGE + (srow + 32 * _i) * KP + sch * 16) = kr[_i]; \
        *(LAS u32x4*)(lds + (buf) * ASTAGE + KBYTES + (srow + 32 * _i) * VP + sch * 16) = vr[_i]; } } while (0)
#define ATT_PV(stage) do { LAS unsigned char* _vb = lds + (stage) * ASTAGE + KBYTES; __builtin_amdgcn_s_setprio(1); \
        _Pragma("unroll") for (int st = 0; st < 2; ++st) _Pragma("unroll") for (int s2 = 0; s2 < 2; ++s2) _Pragma("unroll") for (int d = 0; d < 4; ++d) { \
            const s16x4 lo = __builtin_amdgcn_ds_read_tr16_b64_v4i16((LAS s16x4*)(_vb + vread + (32 * st + 16 * s2) * VP + d * 64)); \
            const s16x4 hi = __builtin_amdgcn_ds_read_tr16_b64_v4i16((LAS s16x4*)(_vb + vread + (32 * st + 16 * s2 + 8) * VP + d * 64)); \
            const bf16x8 vf = __builtin_shufflevector(lo, hi, 0, 1, 2, 3, 4, 5, 6, 7); \
            o[d] = __builtin_amdgcn_mfma_f32_32x32x16_bf16(vf, pf[st][s2], o[d], 0, 0, 0); } \
        __builtin_amdgcn_sched_group_barrier(0x100, 6, 1); \
        _Pragma("unroll") for (int i = 0; i < 16; ++i) { __builtin_amdgcn_sched_group_barrier(0x008, 1, 1); __builtin_amdgcn_sched_group_barrier(0x100, 2, 1); } \
        __builtin_amdgcn_s_setprio(0); } while (0)
    ATT_GLOAD(0); ATT_LSTORE(0);
    const int kread = c * KP + h * 16;
    const int vread = (4 * h + ((lane & 15) >> 2)) * VP + ((lane >> 4) & 1) * 32 + (lane & 3) * 8;
    u32x4 mw4 = {0u, 0u, 0u, 0u};
    int sj = 0, sp = 2;
    for (int j = 0; j < nt; ++j) {
        lds_barrier();
        const int sn = (sj == 2) ? 0 : sj + 1;
        if (j + 1 < nt) ATT_GLOAD(j + 1);
        u32x2 mw = {0u, 0u};
        if (MODE == 0) {
            if ((j & 1) == 0) { if (j <= my_last) mw4 = *(const GAS u32x4*)(maskp + ((size_t)(j >> 1) * SEQ + qpos) * 4); mw.x = mw4.x; mw.y = mw4.y; }
            else { mw.x = mw4.z; mw.y = mw4.w; }
        }
        if (grp == 1 && j >= 1 && j - 1 <= my_last) ATT_PV(sp);
        if (j <= my_last) {
            LAS unsigned char* kb = lds + sj * ASTAGE;
            f32x16 s0, s1;
#pragma unroll
            for (int r = 0; r < 16; ++r) { s0[r] = negMB; s1[r] = negMB; }
            __builtin_amdgcn_s_setprio(1);
#pragma unroll
            for (int ks = 0; ks < 8; ++ks) {
                const bf16x8 k0 = *(const LAS bf16x8*)(kb + kread + ks * 32);
                const bf16x8 k1 = *(const LAS bf16x8*)(kb + kread + 32 * KP + ks * 32);
                s0 = __builtin_amdgcn_mfma_f32_32x32x16_bf16(k0, qf[ks], s0, 0, 0, 0);
                s1 = __builtin_amdgcn_mfma_f32_32x32x16_bf16(k1, qf[ks], s1, 0, 0, 0);
            }
            __builtin_amdgcn_sched_group_barrier(0x100, 6, 0);
#pragma unroll
            for (int i = 0; i < 8; ++i) { __builtin_amdgcn_sched_group_barrier(0x008, 2, 0); __builtin_amdgcn_sched_group_barrier(0x100, 2, 0); }
            __builtin_amdgcn_s_setprio(0);
            if (j * 64 + 63 > q0) {
                const int kbase = j * 64 + 4 * h;
#pragma unroll
                for (int r = 0; r < 16; ++r) { const int key = kbase + (r & 3) + 8 * (r >> 2);
                    if (key > qpos) s0[r] = -INFINITY; if (key + 32 > qpos) s1[r] = -INFINITY; }
            }
#pragma unroll
            for (int r = 0; r < 16; ++r) { s0[r] = fast_exp2(s0[r]); s1[r] = fast_exp2(s1[r]); }
            if (MODE == 0) {
#pragma unroll
                for (int r = 0; r < 16; ++r) { const int bit = (r & 3) + 8 * (r >> 2) + 4 * h;
                    const int m0 = __builtin_amdgcn_sbfe((int)mw.x, bit, 1), m1 = __builtin_amdgcn_sbfe((int)mw.y, bit, 1);
                    s0[r] = __int_as_float(__float_as_int(s0[r]) & m0); s1[r] = __int_as_float(__float_as_int(s1[r]) & m1); }
            }
            float ls = 0.f;
#pragma unroll
            for (int r = 0; r < 16; ++r) ls += s0[r] + s1[r];
            lrun += ls;
#pragma unroll
            for (int s2 = 0; s2 < 2; ++s2) {
                u32x4 w0, w1;
                w0.x = cvt_pk_bf16(s0[8 * s2 + 0], s0[8 * s2 + 1]); w0.y = cvt_pk_bf16(s0[8 * s2 + 2], s0[8 * s2 + 3]); w0.z = cvt_pk_bf16(s0[8 * s2 + 4], s0[8 * s2 + 5]); w0.w = cvt_pk_bf16(s0[8 * s2 + 6], s0[8 * s2 + 7]);
                w1.x = cvt_pk_bf16(s1[8 * s2 + 0], s1[8 * s2 + 1]); w1.y = cvt_pk_bf16(s1[8 * s2 + 2], s1[8 * s2 + 3]); w1.z = cvt_pk_bf16(s1[8 * s2 + 4], s1[8 * s2 + 5]); w1.w = cvt_pk_bf16(s1[8 * s2 + 6], s1[8 * s2 + 7]);
                pf[0][s2] = __builtin_bit_cast(bf16x8, w0); pf[1][s2] = __builtin_bit_cast(bf16x8, w1);
            }
            if (grp == 0) ATT_PV(sj);
        }
        if (j + 1 < nt) ATT_LSTORE(sn);
        sp = sj; sj = sn;
    }
    if (grp == 1 && nt - 1 <= my_last) ATT_PV(sp);
#undef ATT_GLOAD
#undef ATT_LSTORE
#undef ATT_PV
    const float ltot = lrun + __shfl_xor(lrun, 32);
    const float inv = 1.0f / ltot;
#pragma unroll
    for (int d = 0; d < 4; ++d)
#pragma unroll
        for (int g = 0; g < 4; ++g) {
            const int dd = 32 * d + 8 * g + 4 * h;
            float v0 = o[d][4 * g] * inv, v1 = o[d][4 * g + 1] * inv, v2 = o[d][4 * g + 2] * inv, v3 = o[d][4 * g + 3] * inv;
            if (MODE == 0) {
                const u32x2 gw = *(const GAS u32x2*)(sga + (size_t)qpos * 1024 + dd);
                v0 *= bflo(gw.x); v1 *= bfhi(gw.x); v2 *= bflo(gw.y); v3 *= bfhi(gw.y);
                u32x2 w; w.x = cvt_pk_bf16(v0, v1); w.y = cvt_pk_bf16(v2, v3);
                *(GAS u32x2*)(outp + (size_t)qpos * 2048 + dd) = w;
            } else {
                u32x2 w; w.x = cvt_pk_bf16(v0, v1); w.y = cvt_pk_bf16(v2, v3);
                *(GAS u32x2*)(outp + (size_t)qpos * 2048 + dd) = w;
            }
        }
    __syncthreads();
}

constexpr int VP2 = 576, VB2 = 64 * VP2, PSTAGE = KBYTES + VB2  , XBUF_OFF = 2 * PSTAGE  ;
__device__ void attn_pair_block(LAS unsigned char* lds, const bf16_t* Qp, const bf16_t* Kp, const bf16_t* Vp, int qb, bf16_t* outp, const float negMB) {
    const int tid = opaque_tid(), wid = __builtin_amdgcn_readfirstlane(tid >> 6), lane = tid & 63, c = lane & 31, h = lane >> 5;
    const int stw = wid >> 2;
    const int q0 = qb * 128 + (wid & 3) * 32, qpos = q0 + c;
    bf16x8 qf[8];
#pragma unroll
    for (int ks = 0; ks < 8; ++ks) qf[ks] = *(const GAS bf16x8*)(Qp + (size_t)qpos * 1024 + ks * 16 + h * 8);
    f32x16 o[4];
#pragma unroll
    for (int d = 0; d < 4; ++d)
#pragma unroll
        for (int r = 0; r < 16; ++r) o[d][r] = 0.f;
    float lrun = 0.f;
    const int nt = 2 * (qb + 1);
    const int my_last = (q0 + 31) >> 6;
    u32x4 kr[2], vr[4];
#define PB_GLOAD(j) do { _Pragma("unroll") for (int _i = 0; _i < 2; ++_i) { const int _id = tid + 512 * _i; \
            kr[_i] = *(const GAS u32x4*)(Kp + (size_t)((j) * 64 + (_id >> 4)) * 1024 + (_id & 15) * 8); } \
        _Pragma("unroll") for (int _i = 0; _i < 4; ++_i) { const int _id = tid + 512 * _i; \
            vr[_i] = *(const GAS u32x4*)(Vp + (size_t)((j) * 64 + (_id >> 5)) * 1024 + (_id & 31) * 8); } } while (0)
#define PB_LSTORE(buf) do { _Pragma("unroll") for (int _i = 0; _i < 2; ++_i) { const int _id = tid + 512 * _i; \
            *(LAS u32x4*)(lds + (buf) * PSTAGE + (_id >> 4) * KP + (_id & 15) * 16) = kr[_i]; } \
        _Pragma("unroll") for (int _i = 0; _i < 4; ++_i) { const int _id = tid + 512 * _i; \
            *(LAS u32x4*)(lds + (buf) * PSTAGE + KBYTES + (_id >> 5) * VP2 + (_id & 31) * 16) = vr[_i]; } } while (0)
    PB_GLOAD(0); PB_LSTORE(0);
    __syncthreads();
    const int kread = (32 * stw + c) * KP + h * 16;
    const int vread = (4 * h + ((lane & 15) >> 2)) * VP2 + stw * 256 + ((lane >> 4) & 1) * 32 + (lane & 3) * 8;
    LAS unsigned char* xmine = lds + XBUF_OFF + wid * 2048 + lane * 16;
    const LAS unsigned char* xother = lds + XBUF_OFF + (wid ^ 4) * 2048 + lane * 16;
    for (int j = 0; j < nt; ++j) {
        LAS unsigned char* kb = lds + (j & 1) * PSTAGE; LAS unsigned char* vb = kb + KBYTES;
        if (j + 1 < nt) PB_GLOAD(j + 1);
        const bool act = j <= my_last;
        bf16x8 pown[2];
        if (act) {
            f32x16 s0;
#pragma unroll
            for (int r = 0; r < 16; ++r) s0[r] = negMB;
            __builtin_amdgcn_s_setprio(1);
#pragma unroll
            for (int ks = 0; ks < 8; ++ks) { const bf16x8 k0 = *(const LAS bf16x8*)(kb + kread + ks * 32); s0 = __builtin_amdgcn_mfma_f32_32x32x16_bf16(k0, qf[ks], s0, 0, 0, 0); }
            __builtin_amdgcn_sched_group_barrier(0x100, 3, 0);
#pragma unroll
            for (int i = 0; i < 8; ++i) { __builtin_amdgcn_sched_group_barrier(0x008, 1, 0); __builtin_amdgcn_sched_group_barrier(0x100, 1, 0); }
            __builtin_amdgcn_s_setprio(0);
            if (j * 64 + 63 > q0) {
                const int kbase = j * 64 + 32 * stw + 4 * h;
#pragma unroll
                for (int r = 0; r < 16; ++r) { const int key = kbase + (r & 3) + 8 * (r >> 2); if (key > qpos) s0[r] = -INFINITY; }
            }
#pragma unroll
            for (int r = 0; r < 16; ++r) s0[r] = fast_exp2(s0[r]);
            float ls = 0.f;
#pragma unroll
            for (int r = 0; r < 16; ++r) ls += s0[r];
            lrun += ls;
#pragma unroll
            for (int s2 = 0; s2 < 2; ++s2) { u32x4 w0;
                w0.x = cvt_pk_bf16(s0[8 * s2 + 0], s0[8 * s2 + 1]); w0.y = cvt_pk_bf16(s0[8 * s2 + 2], s0[8 * s2 + 3]); w0.z = cvt_pk_bf16(s0[8 * s2 + 4], s0[8 * s2 + 5]); w0.w = cvt_pk_bf16(s0[8 * s2 + 6], s0[8 * s2 + 7]);
                pown[s2] = __builtin_bit_cast(bf16x8, w0); *(LAS u32x4*)(xmine + s2 * 1024) = w0; }
        }
        lds_barrier();
        if (act) {
            bf16x8 poth[2];
#pragma unroll
            for (int s2 = 0; s2 < 2; ++s2) poth[s2] = *(const LAS bf16x8*)(xother + s2 * 1024);
            __builtin_amdgcn_s_setprio(1);
#pragma unroll
            for (int st = 0; st < 2; ++st)
#pragma unroll
                for (int s2 = 0; s2 < 2; ++s2)
#pragma unroll
                    for (int d = 0; d < 4; ++d) {
                        const s16x4 lo = __builtin_amdgcn_ds_read_tr16_b64_v4i16((LAS s16x4*)(vb + vread + (32 * st + 16 * s2) * VP2 + d * 64));
                        const s16x4 hi = __builtin_amdgcn_ds_read_tr16_b64_v4i16((LAS s16x4*)(vb + vread + (32 * st + 16 * s2 + 8) * VP2 + d * 64));
                        const bf16x8 vf = __builtin_shufflevector(lo, hi, 0, 1, 2, 3, 4, 5, 6, 7);
                        const bf16x8 pfr = (st == stw) ? pown[s2] : poth[s2];
                        o[d] = __builtin_amdgcn_mfma_f32_32x32x16_bf16(vf, pfr, o[d], 0, 0, 0);
                    }
            __builtin_amdgcn_sched_group_barrier(0x100, 8, 1);
#pragma unroll
            for (int i = 0; i < 16; ++i) { __builtin_amdgcn_sched_group_barrier(0x008, 1, 1); __builtin_amdgcn_sched_group_barrier(0x100, 2, 1); }
            __builtin_amdgcn_s_setprio(0);
        }
        if (j + 1 < nt) PB_LSTORE((j + 1) & 1);
        lds_barrier();
    }
#undef PB_GLOAD
#undef PB_LSTORE
    float lown = lrun + __shfl_xor(lrun, 32);
    *(LAS float*)(xmine) = lown;
    __syncthreads();
    const float ltot = lown + *(const LAS float*)(xother);
    const float inv = 1.0f / ltot;
#pragma unroll
    for (int d = 0; d < 4; ++d)
#pragma unroll
        for (int g = 0; g < 4; ++g) {
            const int dd = stw * 128 + 32 * d + 8 * g + 4 * h;
            u32x2 w; w.x = cvt_pk_bf16(o[d][4 * g] * inv, o[d][4 * g + 1] * inv); w.y = cvt_pk_bf16(o[d][4 * g + 2] * inv, o[d][4 * g + 3] * inv);
            *(GAS u32x2*)(outp + (size_t)qpos * 2048 + dd) = w;
        }
    __syncthreads();
}

constexpr int IX_QP = 2192  , IX_CAND = 16 * IX_QP  , IX_CNT = IX_CAND + 16 * 512 * 8  ;
__device__ __forceinline__ unsigned lds_add(LAS unsigned* p, unsigned v) { return __hip_atomic_fetch_add(p, v, __ATOMIC_RELAXED, __HIP_MEMORY_SCOPE_WORKGROUP); }
__device__ __forceinline__ void lds_or(LAS unsigned* p, unsigned v) { __hip_atomic_fetch_or(p, v, __ATOMIC_RELAXED, __HIP_MEMORY_SCOPE_WORKGROUP); }
__device__ __forceinline__ unsigned f2key(float x) { const unsigned u = __float_as_uint(x); return (u & 0x80000000u) ? ~u : (u | 0x80000000u); }

template <bool EXACT>
__device__ void select256(LAS unsigned char* lds, int qi, int wid, int lane) {
    LAS u64* cand = (LAS u64*)(lds + IX_CAND) + qi * 512;
    LAS unsigned* cnt = (LAS unsigned*)(lds + IX_CNT);
    const int m = min((int)cnt[qi], 512);
    u64 e[8]; unsigned k[8];
#pragma unroll
    for (int i = 0; i < 8; ++i) { const int idx = lane + 64 * i; e[i] = idx < m ? cand[idx] : 0ull; k[i] = (unsigned)(e[i] >> 16); }
    unsigned T = 0u;
    int cT = m;
#pragma unroll 1
    for (int bit = 31; bit >= 0; --bit) {
        const unsigned trial = T | (1u << bit);
        int c = 0;
#pragma unroll
        for (int i = 0; i < 8; ++i) c += __builtin_popcountll(__ballot(k[i] >= trial));
        if (c >= 256) { T = trial; cT = c; }
        if (!EXACT && cT <= 320) break;
    }
    if (!EXACT) {
        int base = 0;
#pragma unroll
        for (int i = 0; i < 8; ++i) {
            const bool keep = k[i] >= T;
            const u64 bm = __ballot(keep);
            const int pos = base + __builtin_popcountll(bm & ((1ull << lane) - 1ull));
            if (keep) cand[pos] = e[i];
            base += __builtin_popcountll(bm);
        }
        if (lane == 0) { cnt[qi] = (unsigned)base; cnt[32 + qi] = T - 1u; }
        return;
    }
    int g = 0, eq = 0;
#pragma unroll
    for (int i = 0; i < 8; ++i) { g += __builtin_popcountll(__ballot(k[i] > T)); eq += __builtin_popcountll(__ballot(k[i] == T)); }
    const int needeq = 256 - g;
    unsigned L = 0u;
    if (eq > needeq) {
#pragma unroll 1
        for (int bit = 15; bit >= 0; --bit) {
            const unsigned trial = L | (1u << bit);
            int c = 0;
#pragma unroll
            for (int i = 0; i < 8; ++i) c += __builtin_popcountll(__ballot(k[i] == T && (unsigned)(e[i] & 0xFFFFull) >= trial));
            if (c >= needeq) L = trial;
        }
    }
    const u64 thr = ((u64)T << 16) | (u64)L;
    int base = 0;
#pragma unroll
    for (int i = 0; i < 8; ++i) {
        const bool keep = e[i] >= thr;
        const u64 bm = __ballot(keep);
        const int pos = base + __builtin_popcountll(bm & ((1ull << lane) - 1ull));
        if (keep) cand[pos] = e[i];
        base += __builtin_popcountll(bm);
    }
    if (lane == 0) { cnt[qi] = 256u; cnt[32 + qi] = T; }
}

__device__ void indexer_item(LAS unsigned char* lds, const bf16_t* Qi, const bf16_t* Ki, const float* Wi, unsigned* maskout, int qt) {
    const int tid = opaque_tid(), wid = __builtin_amdgcn_readfirstlane(tid >> 6), lane = tid & 63, q = lane & 15, quad = lane >> 4;
    const int t0 = qt * 16;
    LAS unsigned* cnt = (LAS unsigned*)(lds + IX_CNT);
    LAS u64* cand = (LAS u64*)(lds + IX_CAND);
#pragma unroll
    for (int i = 0; i < 4; ++i) { const int id = tid + 512 * i, row = id >> 7, ch = id & 127;
        *(LAS u32x4*)(lds + row * IX_QP + ch * 16) = *(const GAS u32x4*)(Qi + (size_t)(t0 + row) * 1024 + ch * 8); }
    if (tid < 64) cnt[tid] = 0u;
    float wv[16];
#pragma unroll
    for (int i = 0; i < 4; ++i) { const f32x4 w4 = *(const GAS f32x4*)(Wi + (size_t)(t0 + q) * 16 + i * 4); wv[4 * i] = 0.5f * w4[0]; wv[4 * i + 1] = 0.5f * w4[1]; wv[4 * i + 2] = 0.5f * w4[2]; wv[4 * i + 3] = 0.5f * w4[3]; }
    f32x4 wq[4];
#pragma unroll
    for (int i = 0; i < 4; ++i) wq[i] = *(const GAS f32x4*)(Wi + (size_t)(t0 + (tid >> 5)) * 16 + i * 4);
    bf16x8 kn[2][2];
#pragma unroll
    for (int st = 0; st < 2; ++st)
#pragma unroll
        for (int ks = 0; ks < 2; ++ks) kn[st][ks] = *(const GAS bf16x8*)(Ki + (size_t)(wid * 32 + 16 * st + q) * 64 + ks * 32 + quad * 8);
    __syncthreads();
    {
        const int qr = tid >> 5, dp = tid & 31;
        float e0 = 0.f, e1 = 0.f;
#pragma unroll
        for (int i = 0; i < 4; ++i) { const f32x4 w4 = wq[i];
#pragma unroll
            for (int jj = 0; jj < 4; ++jj) { const unsigned v = *(const LAS unsigned*)(lds + qr * IX_QP + (4 * i + jj) * 128 + dp * 4); e0 += w4[jj] * bflo(v); e1 += w4[jj] * bfhi(v); } }
        *(LAS unsigned*)(lds + qr * IX_QP + 16 * 128 + dp * 4) = cvt_pk_bf16(0.5f * e0, 0.5f * e1);
    }
    __syncthreads();
    const int niter = (t0 + 16 + 255) >> 8;
    const int tq = t0 + q;
    const LAS unsigned char* qrow = lds + q * IX_QP + quad * 16;
    unsigned thr = 0u;
    for (int it = 0; it < niter; ++it) {
        const int kb = it * 256 + wid * 32;
        bf16x8 kf[2][2];
#pragma unroll
        for (int st = 0; st < 2; ++st)
#pragma unroll
            for (int ks = 0; ks < 2; ++ks) kf[st][ks] = kn[st][ks];
        { const int itn = (it + 1 < niter) ? it + 1 : it; const int kbn = itn * 256 + wid * 32;
#pragma unroll
          for (int st = 0; st < 2; ++st)
#pragma unroll
            for (int ks = 0; ks < 2; ++ks) kn[st][ks] = *(const GAS bf16x8*)(Ki + (size_t)(kbn + 16 * st + q) * 64 + ks * 32 + quad * 8); }
        const f32x4 z4 = {0.f, 0.f, 0.f, 0.f};
        f32x4 sc0, sc1, c0, c1;
        { const bf16x8 qa = *(const LAS bf16x8*)(qrow + 16 * 128), qb2 = *(const LAS bf16x8*)(qrow + 16 * 128 + 64);
          sc0 = __builtin_amdgcn_mfma_f32_16x16x32_bf16(kf[0][0], qa, z4, 0, 0, 0); sc0 = __builtin_amdgcn_mfma_f32_16x16x32_bf16(kf[0][1], qb2, sc0, 0, 0, 0);
          sc1 = __builtin_amdgcn_mfma_f32_16x16x32_bf16(kf[1][0], qa, z4, 0, 0, 0); sc1 = __builtin_amdgcn_mfma_f32_16x16x32_bf16(kf[1][1], qb2, sc1, 0, 0, 0); }
        { const bf16x8 qa = *(const LAS bf16x8*)(qrow), qb2 = *(const LAS bf16x8*)(qrow + 64);
          c0 = __builtin_amdgcn_mfma_f32_16x16x32_bf16(kf[0][0], qa, z4, 0, 0, 0); c0 = __builtin_amdgcn_mfma_f32_16x16x32_bf16(kf[0][1], qb2, c0, 0, 0, 0);
          c1 = __builtin_amdgcn_mfma_f32_16x16x32_bf16(kf[1][0], qa, z4, 0, 0, 0); c1 = __builtin_amdgcn_mfma_f32_16x16x32_bf16(kf[1][1], qb2, c1, 0, 0, 0); }
#pragma unroll
        for (int hd = 0; hd < 16; ++hd) {
            f32x4 n0 = z4, n1 = z4;
            if (hd < 15) {
                const bf16x8 qa = *(const LAS bf16x8*)(qrow + (hd + 1) * 128), qb2 = *(const LAS bf16x8*)(qrow + (hd + 1) * 128 + 64);
                n0 = __builtin_amdgcn_mfma_f32_16x16x32_bf16(kf[0][0], qa, z4, 0, 0, 0); n0 = __builtin_amdgcn_mfma_f32_16x16x32_bf16(kf[0][1], qb2, n0, 0, 0, 0);
                n1 = __builtin_amdgcn_mfma_f32_16x16x32_bf16(kf[1][0], qa, z4, 0, 0, 0); n1 = __builtin_amdgcn_mfma_f32_16x16x32_bf16(kf[1][1], qb2, n1, 0, 0, 0);
            }
            if (hd < 15)
                asm volatile("v_fma_f32 %0, %16, |%8|, %0\n\tv_fma_f32 %1, %16, |%9|, %1\n\tv_fma_f32 %2, %16, |%10|, %2\n\tv_fma_f32 %3, %16, |%11|, %3\n\t"
                             "v_fma_f32 %4, %16, |%12|, %4\n\tv_fma_f32 %5, %16, |%13|, %5\n\tv_fma_f32 %6, %16, |%14|, %6\n\tv_fma_f32 %7, %16, |%15|, %7"
                             : "+v"(sc0[0]), "+v"(sc0[1]), "+v"(sc0[2]), "+v"(sc0[3]), "+v"(sc1[0]), "+v"(sc1[1]), "+v"(sc1[2]), "+v"(sc1[3])
                             : "v"(c0[0]), "v"(c0[1]), "v"(c0[2]), "v"(c0[3]), "v"(c1[0]), "v"(c1[1]), "v"(c1[2]), "v"(c1[3]), "v"(wv[hd]), "v"(n0), "v"(n1));
            else
                asm volatile("s_nop 15\n\ts_nop 15\n\t"
                             "v_fma_f32 %0, %16, |%8|, %0\n\tv_fma_f32 %1, %16, |%9|, %1\n\tv_fma_f32 %2, %16, |%10|, %2\n\tv_fma_f32 %3, %16, |%11|, %3\n\t"
                             "v_fma_f32 %4, %16, |%12|, %4\n\tv_fma_f32 %5, %16, |%13|, %5\n\tv_fma_f32 %6, %16, |%14|, %6\n\tv_fma_f32 %7, %16, |%15|, %7"
                             : "+v"(sc0[0]), "+v"(sc0[1]), "+v"(sc0[2]), "+v"(sc0[3]), "+v"(sc1[0]), "+v"(sc1[1]), "+v"(sc1[2]), "+v"(sc1[3])
                             : "v"(c0[0]), "v"(c0[1]), "v"(c0[2]), "v"(c0[3]), "v"(c1[0]), "v"(c1[1]), "v"(c1[2]), "v"(c1[3]), "v"(wv[hd]));
            c0 = n0; c1 = n1;
        }
        unsigned k32[8]; int keyi[8];
#pragma unroll
        for (int j = 0; j < 4; ++j) { k32[j] = f2key(sc0[j]); k32[4 + j] = f2key(sc1[j]); keyi[j] = kb + quad * 4 + j; keyi[4 + j] = kb + 16 + quad * 4 + j; }
        int np = 0;
#pragma unroll
        for (int j = 0; j < 8; ++j) np += (keyi[j] <= tq && k32[j] > thr) ? 1 : 0;
        const int cnoff = (it & 1) ? 48 : 16;
        if (np) lds_add(cnt + cnoff + q, (unsigned)np);
        lds_barrier();
        bool round;
        {
            const unsigned both = (lane < 16) ? cnt[lane] + cnt[cnoff + lane] : 0u;
            if (tid < 16) cnt[(cnoff ^ 32) + tid] = 0u;
            round = __ballot(both > 512u) != 0ull;
            if (round) {
#pragma unroll 1
                for (int qq = 0; qq < 2; ++qq) { const int qi = 2 * wid + qq; const unsigned cc = cnt[qi], cn = cnt[cnoff + qi];
                    if (cc + cn > 512u || cc > 320u) {
                        if (cn > 192u || cc <= 320u) select256<true>(lds, qi, wid, lane); else select256<false>(lds, qi, wid, lane); } }
            }
        }
        lds_barrier();
        if (round) thr = cnt[32 + q];
#pragma unroll
        for (int j = 0; j < 8; ++j) if (keyi[j] <= tq && k32[j] > thr) {
            const unsigned pos = lds_add(cnt + q, 1u);
            if (pos < 512u) cand[q * 512 + pos] = ((u64)k32[j] << 16) | (u64)(16383 - keyi[j]);
        }
    }
    __syncthreads();
#pragma unroll 1
    for (int qq = 0; qq < 2; ++qq) { const int qi = 2 * wid + qq; if (cnt[qi] > 256u) select256<true>(lds, qi, wid, lane); }
    __syncthreads();
    LAS unsigned* rows = (LAS unsigned*)lds;
#pragma unroll
    for (int i = 0; i < 4; ++i) *(LAS u32x4*)(rows + (tid + 512 * i) * 4) = (u32x4){0u, 0u, 0u, 0u};
    __syncthreads();
#pragma unroll 1
    for (int qq = 0; qq < 2; ++qq) { const int qi = 2 * wid + qq; const int n = min((int)cnt[qi], 256);
        for (int e = lane; e < n; e += 64) { const u64 ent = cand[qi * 512 + e]; const int key = 16383 - (int)(ent & 0xFFFFull);
            lds_or(rows + qi * 512 + (key >> 5), 1u << (key & 31)); } }
    __syncthreads();
#pragma unroll
    for (int i = 0; i < 4; ++i) { const int id = tid + 512 * i, row = id & 15, jp = id >> 4;
        *(GAS u32x4*)(maskout + ((size_t)jp * SEQ + t0 + row) * 4) = *(const LAS u32x4*)(rows + row * 512 + jp * 4); }
    __syncthreads();
}

__device__ void combine_b(const Params& p) {
    const int tid = opaque_tid(), wid = tid >> 6, lane = tid & 63;
    float s1 = p.lq1[lane] * p.lk1[lane] + p.lq1[lane + 64] * p.lk1[lane + 64];
    float s2 = p.lq2[lane] * p.lk2[lane] + p.lq2[lane + 64] * p.lk2[lane + 64];
#pragma unroll
    for (int o = 32; o >= 1; o >>= 1) { s1 += __shfl_xor(s1, o); s2 += __shfl_xor(s2, o); }
    const float lam = expf(s1) - expf(s2) + 0.2f;
    const bf16_t* ob = (const bf16_t*)((unsigned char*)p.out + DO_OB);
    const bf16_t* sgb = (const bf16_t*)(p.ws + WS_SGB);
    bf16_t* ub = (bf16_t*)(p.ws + WS_UA) + 1024;
    const f32x4 g = *(const GAS f32x4*)(p.subln + lane * 4);
    const int gw = blockIdx.x * 8 + wid, nw = gridDim.x * 8;
    for (int n = gw; n < NTOK; n += nw) {
        u32x2 a[4], b[4], gt[4];
#pragma unroll
        for (int hb = 0; hb < 4; ++hb) {
            a[hb] = *(const GAS u32x2*)(ob + (size_t)n * 2048 + (hb * 2) * 256 + lane * 4);
            b[hb] = *(const GAS u32x2*)(ob + (size_t)n * 2048 + (hb * 2 + 1) * 256 + lane * 4);
            gt[hb] = *(const GAS u32x2*)(sgb + (size_t)n * 1024 + hb * 256 + lane * 4); }
        float v[4][4], ss[4];
#pragma unroll
        for (int hb = 0; hb < 4; ++hb) {
            v[hb][0] = bflo(a[hb].x) - lam * bflo(b[hb].x); v[hb][1] = bfhi(a[hb].x) - lam * bfhi(b[hb].x);
            v[hb][2] = bflo(a[hb].y) - lam * bflo(b[hb].y); v[hb][3] = bfhi(a[hb].y) - lam * bfhi(b[hb].y);
            ss[hb] = v[hb][0] * v[hb][0] + v[hb][1] * v[hb][1] + v[hb][2] * v[hb][2] + v[hb][3] * v[hb][3]; }
#pragma unroll
        for (int o = 32; o >= 1; o >>= 1) {
#pragma unroll
            for (int hb = 0; hb < 4; ++hb) ss[hb] += __shfl_xor(ss[hb], o); }
#pragma unroll
        for (int hb = 0; hb < 4; ++hb) {
            const float r = rsqrtf(ss[hb] * (1.0f / 256.f) + 1e-5f) * 0.8f;
            u32x2 w; w.x = cvt_pk_bf16(v[hb][0] * r * g[0] * bflo(gt[hb].x), v[hb][1] * r * g[1] * bfhi(gt[hb].x));
            w.y = cvt_pk_bf16(v[hb][2] * r * g[2] * bflo(gt[hb].y), v[hb][3] * r * g[3] * bfhi(gt[hb].y));
            *(GAS u32x2*)(ub + (size_t)n * 2048 + hb * 256 + lane * 4) = w; }
    }
}

__global__ void __launch_bounds__(512, 2) mega(Params p_unused) {
    KQ kp = (KQ)__builtin_amdgcn_kernarg_segment_ptr();
    extern __shared__ __attribute__((aligned(16))) unsigned char lds_raw[];
    LAS unsigned char* lds = (LAS unsigned char*)lds_raw;
    cg::grid_group grid = cg::this_grid();
    LAS int* item_slot = (LAS int*)(lds + ITEM_OFF);

    if (blockIdx.x == 0 && threadIdx.x < 64) ((unsigned*)load_params(kp).ws)[threadIdx.x] = 0u;
#ifndef SKIP_P0
    { const Params p = load_params(kp); prep_phase(p, lds); }
#endif
    grid.sync();
#ifndef SKIP_P1
    {
        const Params p = load_params(kp); unsigned char* dout = (unsigned char*)p.out;
        pg8::Gemm g{(const bf16_t*)(dout + DO_H), (const bf16_t*)(p.ws + WS_WINT), NTOK, NP, DM};
        pg8::StaticOrder S; S.init(NTOK, NP, gridDim.x, blockIdx.x);
        EpiIn E{p.ws, (const float*)(dout + DO_COSA), (const float*)(dout + DO_SINA), (const float*)(dout + DO_COSI), (const float*)(dout + DO_SINI),
                p.a_q_gain, p.a_k_gain, p.b_q_gain, p.b_k_gain, (LAS float*)(lds + 131072)};
        pg8::gemm_phase(lds, g, S, E);
    }
#endif
    grid.sync();
#define FETCH_ITEM(base, nitems) do { \
        __syncthreads(); \
        if (tid == 0) { int it, k = xk; for (;;) { const int qx = (xcd + k) & 7; it = (int)atomicAdd(ctr + (base) + qx, 1u); \
                if (it < (nitems)) { it |= qx << 16; break; } if (++k == 8) { it = -1; break; } } \
            item_slot[0] = it; item_slot[1] = k; } \
        __syncthreads(); \
        item = item_slot[0]; xk = item_slot[1]; } while (0)
#ifndef SKIP_P2
    { int xk = 0; const int xcd = blockIdx.x & 7;
    float negMB_b; { const Params p0 = load_params(kp); negMB_b = score_bound_neg(p0.b_q_gain, p0.b_k_gain, threadIdx.x & 63); }
    for (;;) {
        const Params p = load_params(kp); unsigned char* dout = (unsigned char*)p.out; unsigned* ctr = (unsigned*)(p.ws + WS_CTR); const int tid = opaque_tid();
        int item;
        FETCH_ITEM(0, 512);
        if (item < 0) break;
        const int qx = item >> 16, n = item & 0xFFFF;
        if (n < 256) {
            const int qb = 127 - (n >> 1), map = n & 1, b = qx & 1, hb = qx >> 1;
            const size_t tok0 = (size_t)b * SEQ;
            const bf16_t* Q = (const bf16_t*)(p.ws + WS_QB) + tok0 * 1024 + (hb * 2 + map) * 128;
            const bf16_t* K = (const bf16_t*)(p.ws + WS_KB) + tok0 * 1024 + (hb * 2 + map) * 128;
            const bf16_t* V = (const bf16_t*)(p.ws + WS_VB) + tok0 * 1024 + hb * 256;
            bf16_t* O = (bf16_t*)(dout + DO_OB) + tok0 * 2048 + (hb * 2 + map) * 256;
            attn_pair_block(lds, Q, K, V, qb, O, negMB_b);
        } else {
            const int i2 = (n - 256) * 8 + qx, qt = 1023 - (i2 >> 1), b = i2 & 1;
            const size_t tok0 = (size_t)b * SEQ;
            indexer_item(lds, (const bf16_t*)(p.ws + WS_QI) + tok0 * 1024, (const bf16_t*)(p.ws + WS_KI) + tok0 * 64, (const float*)(p.ws + WS_WI) + tok0 * 16,
                         (unsigned*)(dout + DO_MASK) + tok0 * 512, qt);
        }
    } }
#endif
    grid.sync();
#ifndef SKIP_P3
    { const Params p = load_params(kp); combine_b(p); }
    { int xk = 0; const int xcd = blockIdx.x & 7;
    float negMB_a; { const Params p0 = load_params(kp); negMB_a = score_bound_neg(p0.a_q_gain, p0.a_k_gain, threadIdx.x & 63); }
    for (;;) {
        const Params p = load_params(kp); unsigned char* dout = (unsigned char*)p.out; unsigned* ctr = (unsigned*)(p.ws + WS_CTR); const int tid = opaque_tid();
        int item;
        FETCH_ITEM(8, 128);
        if (item < 0) break;
        const int qx = item >> 16, n = item & 0xFFFF;
        const int qb = 63 - (n >> 1), idx = qx + 8 * (n & 1), b = idx & 1, hd = idx >> 1;
        const size_t tok0 = (size_t)b * SEQ;
        attn_block<0>(lds, (const bf16_t*)(p.ws + WS_QA) + tok0 * 1024 + hd * 128, (const bf16_t*)(p.ws + WS_KA) + tok0 * 1024 + hd * 128,
                      (const bf16_t*)(p.ws + WS_VA) + tok0 * 1024 + hd * 128, qb, (const unsigned*)(dout + DO_MASK) + tok0 * 512,
                      (const bf16_t*)(p.ws + WS_SGA) + tok0 * 1024 + hd * 128, (bf16_t*)(p.ws + WS_UA) + tok0 * 2048 + hd * 128, negMB_a);
    } }
#endif
#undef FETCH_ITEM
    grid.sync();
#ifndef SKIP_P4
    {
        const Params p = load_params(kp);
        pg8::StaticOrder S; S.init(NTOK, DM, gridDim.x, blockIdx.x);
        pg8::Gemm gab{(const bf16_t*)(p.ws + WS_UA), (const bf16_t*)(p.ws + WS_WOAT), NTOK, DM, DM};
        EpiMerge Em{(const bf16_t*)(p.ws + WS_SMA), (const bf16_t*)(p.ws + WS_SMB), (bf16_t*)(p.ws + WS_MERGED)};
        pg8::gemm_phase(lds, gab, S, Em);
    }
#endif
    grid.sync();
#ifndef SKIP_P5
    {
        const Params p = load_params(kp);
        pg8::StaticOrder S; S.init(NTOK, DM, gridDim.x, blockIdx.x);
        pg8::Gemm go{(const bf16_t*)(p.ws + WS_MERGED), (const bf16_t*)(p.ws + WS_WOUTT), NTOK, DM, DM};
        EpiOut<2> Eo{nullptr, nullptr, nullptr, p.x, p.out};
        pg8::gemm_phase(lds, go, S, Eo);
    }
#endif
}

extern "C" void kernel_launch(void* const* d_in, const int* in_sizes, int n_in, void* d_out, int out_size, void* d_ws, size_t ws_size, hipStream_t stream) {
    static int grid_blocks = 0;
    if (!grid_blocks) {
        hipFuncSetAttribute((const void*)mega, hipFuncAttributeMaxDynamicSharedMemorySize, LDS_BYTES);
        int dev = 0, cus = 0, per_cu = 0;
        hipGetDevice(&dev);
        hipDeviceGetAttribute(&cus, hipDeviceAttributeMultiprocessorCount, dev);
        hipOccupancyMaxActiveBlocksPerMultiprocessor(&per_cu, mega, 512, LDS_BYTES);
        if (per_cu < 1) per_cu = 1;
        grid_blocks = cus * 1;
    }
    Params p{};
    p.x = (const float*)d_in[0]; p.pos = (const int*)d_in[1]; p.norm_gain = (const float*)d_in[2]; p.w_in = (const float*)d_in[3];
    p.a_q_gain = (const float*)d_in[4]; p.a_k_gain = (const float*)d_in[5]; p.b_q_gain = (const float*)d_in[6]; p.b_k_gain = (const float*)d_in[7];
    p.lq1 = (const float*)d_in[8]; p.lk1 = (const float*)d_in[9]; p.lq2 = (const float*)d_in[10]; p.lk2 = (const float*)d_in[11]; p.subln = (const float*)d_in[12];
    p.w_o_a = (const float*)d_in[13]; p.w_o_b = (const float*)d_in[14]; p.w_out = (const float*)d_in[15];
    p.out = (float*)d_out; p.ws = (unsigned char*)d_ws;
    void* args[] = {&p};
    hipError_t e = hipLaunchCooperativeKernel((void*)mega, dim3(grid_blocks), dim3(512), args, LDS_BYTES, stream);
    if (e != hipSuccess) fprintf(stderr, "cooperative launch failed: %s (grid %d)\n", hipGetErrorString(e), grid_blocks);
}
```

```cpp
#include <hip/hip_runtime.h>
#include <hip/hip_cooperative_groups.h>
#include <cstdio>
#include <cstdint>
namespace cg = cooperative_groups;

#define LAS __attribute__((address_space(3)))
#define GAS __attribute__((address_space(1)))
typedef unsigned short bf16_t;
typedef short bf16x8 __attribute__((ext_vector_type(8)));
typedef short s16x4 __attribute__((ext_vector_type(4)));
typedef float f32x4 __attribute__((ext_vector_type(4)));
typedef float f32x16 __attribute__((ext_vector_type(16)));
typedef unsigned u32x4 __attribute__((ext_vector_type(4)));
typedef unsigned u32x2 __attribute__((ext_vector_type(2)));
typedef unsigned long long u64;

constexpr int SEQ = 16384, NTOK = 32768, DM = 2048, INC = 13392, NP = 13568;
constexpr int LDS_BYTES = 131072 + 8192 + 64;
constexpr int ITEM_OFF = 131072 + 8192;
constexpr float QSCALE = 0.08838834764831845f * 1.4426950408889634f;

struct Params {
    const float* x; const int* pos; const float* norm_gain; const float* w_in;
    const float* a_q_gain; const float* a_k_gain; const float* b_q_gain; const float* b_k_gain;
    const float* lq1; const float* lk1; const float* lq2; const float* lk2; const float* subln;
    const float* w_o_a; const float* w_o_b; const float* w_out;
    float* out; unsigned char* ws;
};

typedef const __attribute__((address_space(4))) unsigned long long* KQ;
__device__ __forceinline__ Params load_params(KQ kq) {
    asm volatile("" : "+s"(kq));
    Params p;
    p.x = (const float*)kq[0]; p.pos = (const int*)kq[1]; p.norm_gain = (const float*)kq[2]; p.w_in = (const float*)kq[3];
    p.a_q_gain = (const float*)kq[4]; p.a_k_gain = (const float*)kq[5]; p.b_q_gain = (const float*)kq[6]; p.b_k_gain = (const float*)kq[7];
    p.lq1 = (const float*)kq[8]; p.lk1 = (const float*)kq[9]; p.lq2 = (const float*)kq[10]; p.lk2 = (const float*)kq[11]; p.subln = (const float*)kq[12];
    p.w_o_a = (const float*)kq[13]; p.w_o_b = (const float*)kq[14]; p.w_out = (const float*)kq[15];
    p.out = (float*)kq[16]; p.ws = (unsigned char*)kq[17];
    return p;
}

constexpr size_t MiB = 1u << 20;
constexpr size_t WS_CTR = 0;
constexpr size_t WS_WINT = 1 * MiB;
constexpr size_t WS_WOAT = 54 * MiB, WS_WOBT = 58 * MiB, WS_WOUTT = 62 * MiB;
constexpr size_t WS_QA = 70 * MiB, WS_KA = 134 * MiB, WS_VA = 198 * MiB, WS_SGA = 262 * MiB;
constexpr size_t WS_QI = 326 * MiB, WS_KI = 390 * MiB, WS_WI = 394 * MiB;
constexpr size_t WS_QB = 396 * MiB, WS_KB = 460 * MiB, WS_VB = 524 * MiB, WS_SGB = 588 * MiB;
constexpr size_t WS_SMA = 652 * MiB, WS_SMB = 780 * MiB;
constexpr size_t WS_UA = WS_QB, WS_UB = WS_KB;
constexpr size_t WS_MERGED = WS_QA;
constexpr size_t DO_H = 0, DO_OB = 0, DO_MASK = 128 * MiB, DO_COSA = 192 * MiB, DO_SINA = 200 * MiB, DO_COSI = 208 * MiB, DO_SINI = 212 * MiB;

__device__ __forceinline__ unsigned cvt_pk_bf16(float lo, float hi) { unsigned r; asm volatile("v_cvt_pk_bf16_f32 %0, %1, %2" : "=v"(r) : "v"(lo), "v"(hi)); return r; }
__device__ __forceinline__ float bf2f(unsigned short b) { return __uint_as_float(((unsigned)b) << 16); }
__device__ __forceinline__ float bflo(unsigned w) { return __uint_as_float(w << 16); }
__device__ __forceinline__ float bfhi(unsigned w) { return __uint_as_float(w & 0xffff0000u); }
__device__ __forceinline__ float fast_exp2(float x) { return __builtin_amdgcn_exp2f(x); }
__device__ __forceinline__ float sigmoidf_(float x) { return __builtin_amdgcn_rcpf(1.0f + __builtin_amdgcn_exp2f(-1.4426950408889634f * x)); }

__device__ __forceinline__ void lds_barrier() { asm volatile("s_waitcnt lgkmcnt(0)" ::: "memory"); __builtin_amdgcn_s_barrier(); asm volatile("" ::: "memory"); }
__device__ __forceinline__ int opaque_tid() { int t = threadIdx.x; asm volatile("" : "+v"(t)); return t; }

__device__ __forceinline__ int orig_col(int c) {
    if (c < 4096) { int seg = c >> 10, w = c & 1023; if (seg < 2) { int hd = w >> 7, p = w & 127; w = hd * 128 + (p & 1) * 64 + (p >> 1); } return seg * 1024 + w; }
    if (c < 5120) { int w = c - 4096; int hd = w >> 6, p = w & 63; return 4096 + hd * 64 + (p & 1) * 32 + (p >> 1); }
    if (c < 9216) { int w0 = c - 5120; int seg = w0 >> 10, w = w0 & 1023; if (seg < 2) { int hd = w >> 7, p = w & 127; w = hd * 128 + (p & 1) * 64 + (p >> 1); } return 5200 + seg * 1024 + w; }
    if (c < 13312) return 9296 + (c - 9216);
    int w = c - 13312;
    if (w < 64) return 5120 + (w & 1) * 32 + (w >> 1);
    if (w < 80) return 5184 + (w - 64);
    return -1;
}

template <bool MAPPED>
__device__ void transpose_convert(LAS unsigned char* lds, const float* src, int src_ld, int K, int ncols, bf16_t* dst, int dst_ld, int k_off, int tile0, int tstride) {
    LAS float* tile = (LAS float*)lds;
    const int tid = opaque_tid(), ktiles = K / 256, ntiles = (ncols / 64) * ktiles;
    for (int t = tile0; t < ntiles; t += tstride) {
        const int ct = t / ktiles, kt = t % ktiles, c0 = ct * 64, k0 = kt * 256;
        const int i = tid & 63, j = tid >> 6;
        const int oc = MAPPED ? orig_col(c0 + i) : (c0 + i);
        float v[32];
#pragma unroll
        for (int kk = 0; kk < 32; ++kk) v[kk] = (oc >= 0) ? __builtin_nontemporal_load((const GAS float*)(src + (size_t)(k0 + j + 8 * kk) * src_ld + oc)) : 0.f;
#pragma unroll
        for (int kk = 0; kk < 32; ++kk) tile[(j + 8 * kk) * 65 + i] = v[kk];
        __syncthreads();
#pragma unroll
        for (int u = 0; u < 4; ++u) {
            const int id = tid + 512 * u, q = ((id >> 8) << 2) | (id & 3), r = (id >> 2) & 63;
            u32x4 w;
            w.x = cvt_pk_bf16(tile[(q * 8 + 0) * 65 + r], tile[(q * 8 + 1) * 65 + r]); w.y = cvt_pk_bf16(tile[(q * 8 + 2) * 65 + r], tile[(q * 8 + 3) * 65 + r]);
            w.z = cvt_pk_bf16(tile[(q * 8 + 4) * 65 + r], tile[(q * 8 + 5) * 65 + r]); w.w = cvt_pk_bf16(tile[(q * 8 + 6) * 65 + r], tile[(q * 8 + 7) * 65 + r]);
            *(GAS u32x4*)(dst + (size_t)(c0 + r) * dst_ld + k_off + k0 + q * 8) = w;
        }
        __syncthreads();
    }
}

__device__ void prep_phase(const Params& p, LAS unsigned char* lds) {
    const int tid = opaque_tid(), wid = tid >> 6, lane = tid & 63;
    unsigned char* dout = (unsigned char*)p.out;
    {
        bf16_t* H = (bf16_t*)(dout + DO_H);
        const int gw = blockIdx.x * 8 + wid, nw = gridDim.x * 8;
        for (int n0 = gw; n0 < NTOK; n0 += 2 * nw) {
            const int n1 = n0 + nw;
            const float* xr0 = p.x + (size_t)n0 * DM; const float* xr1 = p.x + (size_t)n1 * DM;
            f32x4 v0[8], v1[8]; float s0 = 0.f, s1 = 0.f;
#pragma unroll
            for (int i = 0; i < 8; ++i) { v0[i] = __builtin_nontemporal_load((const GAS f32x4*)(xr0 + i * 256 + lane * 4)); v1[i] = __builtin_nontemporal_load((const GAS f32x4*)(xr1 + i * 256 + lane * 4)); }
#pragma unroll
            for (int i = 0; i < 8; ++i) { s0 += v0[i][0] * v0[i][0] + v0[i][1] * v0[i][1] + v0[i][2] * v0[i][2] + v0[i][3] * v0[i][3];
                                          s1 += v1[i][0] * v1[i][0] + v1[i][1] * v1[i][1] + v1[i][2] * v1[i][2] + v1[i][3] * v1[i][3]; }
#pragma unroll
            for (int o = 32; o >= 1; o >>= 1) { s0 += __shfl_xor(s0, o); s1 += __shfl_xor(s1, o); }
            const float r0 = rsqrtf(s0 * (1.0f / DM) + 1e-6f), r1 = rsqrtf(s1 * (1.0f / DM) + 1e-6f);
#pragma unroll
            for (int i = 0; i < 8; ++i) { const f32x4 g = *(const GAS f32x4*)(p.norm_gain + i * 256 + lane * 4);
                u32x2 w; w.x = cvt_pk_bf16(v0[i][0] * r0 * g[0], v0[i][1] * r0 * g[1]); w.y = cvt_pk_bf16(v0[i][2] * r0 * g[2], v0[i][3] * r0 * g[3]);
                *(GAS u32x2*)(H + (size_t)n0 * DM + i * 256 + lane * 4) = w;
                u32x2 w2; w2.x = cvt_pk_bf16(v1[i][0] * r1 * g[0], v1[i][1] * r1 * g[1]); w2.y = cvt_pk_bf16(v1[i][2] * r1 * g[2], v1[i][3] * r1 * g[3]);
                *(GAS u32x2*)(H + (size_t)n1 * DM + i * 256 + lane * 4) = w2; }
        }
    }
    {
        float* cosA = (float*)(dout + DO_COSA); float* sinA = (float*)(dout + DO_SINA); float* cosI = (float*)(dout + DO_COSI); float* sinI = (float*)(dout + DO_SINI);
        LAS float* invf = (LAS float*)(lds + 32768);
        if (tid < 64) invf[tid] = (float)pow(10000.0, -(double)(2 * tid) / 128.0);
        else if (tid < 96) invf[tid] = (float)pow(10000.0, -(double)(2 * (tid - 64)) / 64.0);
        __syncthreads();
        const int gt = blockIdx.x * 512 + tid, nthr = gridDim.x * 512;
        for (int e = gt; e < NTOK * 96; e += nthr) {
            const int n = e / 96, i = e % 96;
            const float a = (float)p.pos[n] * invf[i];
            float sv, cv; sincosf(a, &sv, &cv);
            if (i < 64) { cosA[(size_t)n * 64 + i] = cv; sinA[(size_t)n * 64 + i] = sv; }
            else { cosI[(size_t)n * 32 + (i - 64)] = cv; sinI[(size_t)n * 32 + (i - 64)] = sv; }
        }
        __syncthreads();
    }
    transpose_convert<true>(lds, p.w_in, INC, DM, NP, (bf16_t*)(p.ws + WS_WINT), DM, 0, blockIdx.x, gridDim.x);
    transpose_convert<false>(lds, p.w_o_a, DM, 1024, DM, (bf16_t*)(p.ws + WS_WOAT), DM, 0, blockIdx.x, gridDim.x);
    transpose_convert<false>(lds, p.w_o_b, DM, 1024, DM, (bf16_t*)(p.ws + WS_WOAT), DM, 1024, blockIdx.x, gridDim.x);
    transpose_convert<false>(lds, p.w_out, DM, DM, DM, (bf16_t*)(p.ws + WS_WOUTT), DM, 0, blockIdx.x, gridDim.x);
}

namespace pg8 {
constexpr int BM = 256, BK = 64, HALF = 128, HTB = HALF * BK * 2, STAGE_BYTES = 8 * HTB, NXCD = 8, WGM = 8;
__device__ __forceinline__ int lds_byte(int r, int c) { const int st = (r >> 4) * 2 + (c >> 5), rr = r & 15, cc = c & 31, ob = rr * 64 + cc * 2; return st * 1024 + (ob ^ (((ob >> 9) & 1) << 5)); }
__device__ __forceinline__ void stage_rc(int b, int& R, int& C) { const int st = b / 1024, sb = b % 1024, swz = sb ^ (((sb >> 9) & 1) << 5); R = (st >> 1) * 16 + swz / 64; C = (st & 1) * 32 + (swz % 64) / 2; }
__device__ __forceinline__ int perm32(int rho) { const int n = rho >> 4, i = rho & 15; return 8 * (i >> 2) + 4 * n + (i & 3); }
struct Unit { int pm, pn; };
struct Gemm { const bf16_t* A; const bf16_t* Bt; int M, N, K; };
struct StaticOrder {
    int nM, nN, nwg, G, c;
    __device__ void init(int M, int N, int G_, int c_) { nM = M / BM; nN = N / BM; nwg = nM * nN; G = G_; c = c_; }
    __device__ bool next(int i, Unit& u) const {
        const long L = (long)i * G + c; if (L >= nwg) return false;
        int wgid = (int)L; { const int q = nwg / NXCD, r = nwg % NXCD, xcd = wgid % NXCD, off = wgid / NXCD; wgid = (xcd < r ? xcd * (q + 1) : r * (q + 1) + (xcd - r) * q) + off; }
        const int nig = WGM * nN, gid = wgid / nig, fm = gid * WGM, gsz = (nM - fm) < WGM ? (nM - fm) : WGM;
        u.pm = fm + ((wgid % nig) % gsz); u.pn = (wgid % nig) / gsz; return true;
    }
};

template <class Epi>
__device__ __forceinline__ void gemm_phase(LAS unsigned char* lds, const Gemm g, const StaticOrder& S, const Epi& E) {
    const int tid = opaque_tid(), wid = __builtin_amdgcn_readfirstlane(tid >> 6), lane = tid & 63, wr = wid >> 2, wc = wid & 3, fr = lane & 15, fq = lane >> 4;
    const int K = g.K, nt = K / BK;
    unsigned voffA[2], voffB[2];
#pragma unroll
    for (int i = 0; i < 2; ++i) { int R, C; stage_rc(tid * 16 + i * 8192, R, C); const int Rb = (R & ~31) + perm32(R & 31);
        voffA[i] = (unsigned)(R * K + C) * 2u; voffB[i] = (unsigned)(Rb * K + C) * 2u; }
    const size_t kstep = (size_t)(BK * 2);
    const size_t hstep = (size_t)HALF * K * 2;
    const size_t tstep = 2 * hstep;
    const unsigned ldsw = (unsigned)wid * 1024u;
    const int aoff = lds_byte(wr * 64 + fr, fq * 8), boff = lds_byte(wc * 32 + fr, fq * 8);
#define PG8_SA(b, h) (((b) * 2 + (h)) * HTB)
#define PG8_SB(b, h) ((4 + (b) * 2 + (h)) * HTB)
#define PG8_STAGE(bufoff, gbase, voff) do { _Pragma("unroll") for (int _i = 0; _i < 2; ++_i) \
        __builtin_amdgcn_global_load_lds((const unsigned*)((const char*)(gbase) + (voff)[_i]), (LAS unsigned*)(lds + (bufoff) + ldsw + _i * 8192), 16, 0, 0); } while (0)
#define PG8_LDA(dst, b, h) do { _Pragma("unroll") for (int m = 0; m < 4; ++m) _Pragma("unroll") for (int k = 0; k < 2; ++k) dst[m][k] = *(const LAS bf16x8*)(lds + PG8_SA(b, h) + aoff + m * 2048 + k * 1024); } while (0)
#define PG8_LDB(dst, b, h) do { _Pragma("unroll") for (int n = 0; n < 2; ++n) _Pragma("unroll") for (int k = 0; k < 2; ++k) dst[n][k] = *(const LAS bf16x8*)(lds + PG8_SB(b, h) + boff + n * 2048 + k * 1024); } while (0)
#define PG8_MMA(ai, bj, At, Bt) do { __builtin_amdgcn_s_setprio(1); _Pragma("unroll") for (int m = 0; m < 4; ++m) _Pragma("unroll") for (int n = 0; n < 2; ++n) _Pragma("unroll") for (int k = 0; k < 2; ++k) \
        acc[ai][bj][m][n] = __builtin_amdgcn_mfma_f32_16x16x32_bf16(Bt[n][k], At[m][k], acc[ai][bj][m][n], 0, 0, 0); __builtin_amdgcn_s_setprio(0); } while (0)
#define PG8_WAIT_V(n) asm volatile("s_waitcnt vmcnt(" #n ")" ::: "memory")
#define PG8_WAIT_L(n) asm volatile("s_waitcnt lgkmcnt(" #n ")" ::: "memory")
#define PG8_BAR __builtin_amdgcn_s_barrier()
#define PG8_SCHED __builtin_amdgcn_sched_barrier(0)
    Unit cur, nxt; int ui = 0;
    if (!S.next(0, cur)) return;
    f32x4 acc[2][2][4][2];
#pragma unroll
    for (int a = 0; a < 2; ++a)
#pragma unroll
        for (int b = 0; b < 2; ++b)
#pragma unroll
            for (int m = 0; m < 4; ++m)
#pragma unroll
                for (int n = 0; n < 2; ++n) acc[a][b][m][n] = (f32x4){0.f, 0.f, 0.f, 0.f};
    bf16x8 At[4][2], B0[2][2], B1[2][2];
    const char* cA = (const char*)g.A + (size_t)cur.pm * tstep; const char* cB = (const char*)g.Bt + (size_t)cur.pn * tstep;
    PG8_STAGE(PG8_SB(0, 0), cB, voffB); PG8_STAGE(PG8_SA(0, 0), cA, voffA); PG8_STAGE(PG8_SB(0, 1), cB + hstep, voffB); PG8_STAGE(PG8_SA(0, 1), cA + hstep, voffA);
    if (wr == 1) PG8_BAR;
    PG8_WAIT_V(4); PG8_BAR;
    PG8_STAGE(PG8_SB(1, 0), cB + kstep, voffB); PG8_STAGE(PG8_SA(1, 0), cA + kstep, voffA); PG8_STAGE(PG8_SB(1, 1), cB + hstep + kstep, voffB);
    PG8_WAIT_V(6); PG8_BAR;
    for (;;) {
        const bool has_next = S.next(ui + 1, nxt);
        const char* nA = has_next ? (const char*)g.A + (size_t)nxt.pm * tstep : cA; const char* nB = has_next ? (const char*)g.Bt + (size_t)nxt.pn * tstep : cB;
        for (int t = 0; t < nt; t += 2) {
            if (Epi::MID_T >= 0 && t == Epi::MID_T) E.mid(acc, cur, wr, wc, fr, fq);
            const bool last = (t == nt - 2);
            const char* a1 = cA + (size_t)(t + 1) * kstep;
            const char* a2 = last ? nA : cA + (size_t)(t + 2) * kstep; const char* b2 = last ? nB : cB + (size_t)(t + 2) * kstep;
            const char* a3 = a2 + kstep; const char* b3 = b2 + kstep;
            PG8_LDB(B0, 0, 0); PG8_SCHED; PG8_LDA(At, 0, 0); PG8_STAGE(PG8_SA(1, 1), a1 + hstep, voffA);
            PG8_WAIT_L(8); PG8_BAR; PG8_WAIT_L(0); PG8_MMA(0, 0, At, B0); PG8_BAR; PG8_SCHED;
            PG8_LDB(B1, 0, 1); PG8_STAGE(PG8_SB(0, 0), b2, voffB);
            PG8_BAR; PG8_WAIT_L(0); PG8_MMA(0, 1, At, B1); PG8_BAR;
            PG8_LDA(At, 0, 1); PG8_STAGE(PG8_SA(0, 0), a2, voffA);
            PG8_BAR; PG8_WAIT_L(0); PG8_MMA(1, 0, At, B0); PG8_BAR; PG8_SCHED;
            PG8_STAGE(PG8_SB(0, 1), b2 + hstep, voffB);
            PG8_WAIT_V(6); PG8_BAR; PG8_MMA(1, 1, At, B1); PG8_BAR;
            PG8_LDB(B0, 1, 0); PG8_SCHED; PG8_LDA(At, 1, 0); PG8_STAGE(PG8_SA(0, 1), a2 + hstep, voffA);
            PG8_WAIT_L(8); PG8_BAR; PG8_WAIT_L(0); PG8_MMA(0, 0, At, B0); PG8_BAR; PG8_SCHED;
            PG8_LDB(B1, 1, 1); PG8_STAGE(PG8_SB(1, 0), b3, voffB);
            PG8_BAR; PG8_WAIT_L(0); PG8_MMA(0, 1, At, B1); PG8_BAR;
            PG8_LDA(At, 1, 1); PG8_STAGE(PG8_SA(1, 0), a3, voffA);
            PG8_BAR; PG8_WAIT_L(0); PG8_MMA(1, 0, At, B0); PG8_BAR; PG8_SCHED;
            PG8_STAGE(PG8_SB(1, 1), b3 + hstep, voffB);
            PG8_WAIT_V(6); PG8_BAR; PG8_MMA(1, 1, At, B1); PG8_BAR;
        }
        E(acc, cur, wr, wc, fr, fq);
        if (!has_next) break;
#pragma unroll
        for (int a = 0; a < 2; ++a)
#pragma unroll
            for (int b = 0; b < 2; ++b)
#pragma unroll
                for (int m = 0; m < 4; ++m)
#pragma unroll
                    for (int n = 0; n < 2; ++n) acc[a][b][m][n] = (f32x4){0.f, 0.f, 0.f, 0.f};
        cur = nxt; cA = nA; cB = nB; ++ui;
    }
    PG8_WAIT_V(0);
    if (wr == 0) PG8_BAR;
    PG8_BAR;
#undef PG8_SA
#undef PG8_SB
#undef PG8_STAGE
#undef PG8_LDA
#undef PG8_LDB
#undef PG8_MMA
#undef PG8_WAIT_V
#undef PG8_WAIT_L
#undef PG8_SCHED
}
}

struct EpiIn {
    static constexpr int MID_T = -1;
    __device__ __forceinline__ void mid(f32x4 (&)[2][2][4][2], const pg8::Unit&, int, int, int, int) const {}
    unsigned char* ws; const float* cosA; const float* sinA; const float* cosI; const float* sinI;
    const float* gaq; const float* gak; const float* gbq; const float* gbk;
    LAS float* red;
    __device__ __forceinline__ void operator()(const f32x4 (&acc)[2][2][4][2], const pg8::Unit& u, int wr, int wc, int fr_in, int fq_in) const {
        int fr = fr_in, fq = fq_in; asm volatile("" : "+v"(fr), "+v"(fq));
        const int pn = u.pn;
        const int row0 = u.pm * 256 + wr * 64 + fr;
        const int cw = wc * 32 + fq * 8;
        int mode; bf16_t* dst; int ldc = 1024, colbase; const float* gain = nullptr; float qs = 1.f;
        if (pn < 16) { const int seg = pn >> 2; colbase = (pn & 3) * 256;
            dst = (bf16_t*)(ws + (seg == 0 ? WS_QA : seg == 1 ? WS_KA : seg == 2 ? WS_VA : WS_SGA));
            mode = seg < 2 ? 4 : (seg == 2 ? 0 : 1); gain = seg == 0 ? gaq : gak; qs = seg == 0 ? QSCALE : 1.f; }
        else if (pn < 20) { colbase = (pn - 16) * 256; dst = (bf16_t*)(ws + WS_QI); mode = 3; }
        else if (pn < 36) { const int seg = (pn - 20) >> 2; colbase = ((pn - 20) & 3) * 256;
            dst = (bf16_t*)(ws + (seg == 0 ? WS_QB : seg == 1 ? WS_KB : seg == 2 ? WS_VB : WS_SGB));
            mode = seg < 2 ? 4 : (seg == 2 ? 0 : 1); gain = seg == 0 ? gbq : gbk; qs = seg == 0 ? QSCALE : 1.f; }
        else if (pn < 44) { colbase = (pn - 36) * 256; dst = (bf16_t*)(ws + WS_SMA); ldc = 2048; mode = 2; }
        else if (pn < 52) { colbase = (pn - 44) * 256; dst = (bf16_t*)(ws + WS_SMB); ldc = 2048; mode = 2; }
        else { colbase = 0; dst = (bf16_t*)(ws + WS_KI); ldc = 64; mode = 5; }

        if (mode == 4) {
            LAS float* redw = red + ((wr * 64 + fr) * 2) * 4 + wc;
            const LAS float* redr = red + ((wr * 64 + fr) * 2) * 4;
#pragma unroll
            for (int ai = 0; ai < 2; ++ai)
#pragma unroll
                for (int m = 0; m < 4; ++m)
#pragma unroll
                    for (int bj = 0; bj < 2; ++bj) {
                        const f32x4 a = acc[ai][bj][m][0], b = acc[ai][bj][m][1];
                        float ss = a[0] * a[0] + a[1] * a[1] + a[2] * a[2] + a[3] * a[3] + b[0] * b[0] + b[1] * b[1] + b[2] * b[2] + b[3] * b[3];
                        ss += __shfl_xor(ss, 16); ss += __shfl_xor(ss, 32);
                        if (fq == 0) redw[((ai * 128 + m * 16) * 2 + bj) * 4] = ss;
                        __builtin_amdgcn_sched_barrier(0);
                    }
            asm volatile("s_waitcnt lgkmcnt(0)" ::: "memory");
            __builtin_amdgcn_s_barrier();
            const int pi0 = cw >> 1;
            const f32x4 g1 = *(const GAS f32x4*)(gain + pi0), g2 = *(const GAS f32x4*)(gain + 64 + pi0);
#pragma unroll
            for (int ai = 0; ai < 2; ++ai)
#pragma unroll
                for (int m = 0; m < 4; ++m) {
                    const int rl = ai * 128 + wr * 64 + m * 16 + fr; const int row = u.pm * 256 + rl;
                    const f32x4 cs = *(const GAS f32x4*)(cosA + (size_t)row * 64 + pi0), sn = *(const GAS f32x4*)(sinA + (size_t)row * 64 + pi0);
#pragma unroll
                    for (int bj = 0; bj < 2; ++bj) {
                        const f32x4 r4 = *(const LAS f32x4*)(redr + ((ai * 128 + m * 16) * 2 + bj) * 4);
                        const float inv = rsqrtf((r4[0] + r4[1] + r4[2] + r4[3]) * (1.0f / 128.f) + 1e-6f) * qs;
                        const f32x4 a = acc[ai][bj][m][0], b = acc[ai][bj][m][1];
                        const float x1a = a[0] * inv * g1[0], x2a = a[1] * inv * g2[0], x1b = a[2] * inv * g1[1], x2b = a[3] * inv * g2[1];
                        const float x1c = b[0] * inv * g1[2], x2c = b[1] * inv * g2[2], x1d = b[2] * inv * g1[3], x2d = b[3] * inv * g2[3];
                        u32x4 w;
                        w.x = cvt_pk_bf16(x1a * cs[0] - x2a * sn[0], x2a * cs[0] + x1a * sn[0]);
                        w.y = cvt_pk_bf16(x1b * cs[1] - x2b * sn[1], x2b * cs[1] + x1b * sn[1]);
                        w.z = cvt_pk_bf16(x1c * cs[2] - x2c * sn[2], x2c * cs[2] + x1c * sn[2]);
                        w.w = cvt_pk_bf16(x1d * cs[3] - x2d * sn[3], x2d * cs[3] + x1d * sn[3]);
                        __builtin_nontemporal_store(w, (GAS u32x4*)(dst + (size_t)row * ldc + colbase + bj * 128 + cw));
                    }
                    __builtin_amdgcn_sched_barrier(0);
                }
            return;
        }
        if (mode == 3 || mode == 5) {
            const int pi0 = (cw & 63) >> 1;
#pragma unroll
            for (int ai = 0; ai < 2; ++ai)
#pragma unroll
                for (int m = 0; m < 4; ++m) {
                    const int row = row0 + ai * 128 + m * 16;
                    const f32x4 cs = *(const GAS f32x4*)(cosI + (size_t)row * 32 + pi0), sn = *(const GAS f32x4*)(sinI + (size_t)row * 32 + pi0);
#pragma unroll
                    for (int bj = 0; bj < 2; ++bj) {
                        const f32x4 a = acc[ai][bj][m][0], b = acc[ai][bj][m][1];
                        if (mode == 5) {
                            if (bj == 1 || wc == 3) continue;
                            if (wc == 2) { if (fq < 2) { float* wi = (float*)(ws + WS_WI) + (size_t)row * 16 + fq * 8;
                                    *(GAS f32x4*)wi = a * 0.03125f; *(GAS f32x4*)(wi + 4) = b * 0.03125f; }
                                continue; }
                        }
                        u32x4 w;
                        w.x = cvt_pk_bf16(a[0] * cs[0] - a[1] * sn[0], a[1] * cs[0] + a[0] * sn[0]);
                        w.y = cvt_pk_bf16(a[2] * cs[1] - a[3] * sn[1], a[3] * cs[1] + a[2] * sn[1]);
                        w.z = cvt_pk_bf16(b[0] * cs[2] - b[1] * sn[2], b[1] * cs[2] + b[0] * sn[2]);
                        w.w = cvt_pk_bf16(b[2] * cs[3] - b[3] * sn[3], b[3] * cs[3] + b[2] * sn[3]);
                        __builtin_nontemporal_store(w, (GAS u32x4*)(dst + (size_t)row * ldc + colbase + bj * 128 + cw));
                    }
                    __builtin_amdgcn_sched_barrier(0);
                }
            return;
        }
#pragma unroll
        for (int ai = 0; ai < 2; ++ai)
#pragma unroll
            for (int m = 0; m < 4; ++m) {
                const int row = row0 + ai * 128 + m * 16;
#pragma unroll
                for (int bj = 0; bj < 2; ++bj) {
                    f32x4 a = acc[ai][bj][m][0], b = acc[ai][bj][m][1];
                    if (mode == 1) {
#pragma unroll
                        for (int j = 0; j < 4; ++j) { a[j] = a[j] * sigmoidf_(a[j]); b[j] = b[j] * sigmoidf_(b[j]); } }
                    else if (mode == 2) {
#pragma unroll
                        for (int j = 0; j < 4; ++j) { a[j] = sigmoidf_(a[j]); b[j] = sigmoidf_(b[j]); } }
                    u32x4 w; w.x = cvt_pk_bf16(a[0], a[1]); w.y = cvt_pk_bf16(a[2], a[3]); w.z = cvt_pk_bf16(b[0], b[1]); w.w = cvt_pk_bf16(b[2], b[3]);
                    __builtin_nontemporal_store(w, (GAS u32x4*)(dst + (size_t)row * ldc + colbase + bj * 128 + cw));
                }
                __builtin_amdgcn_sched_barrier(0);
            }
    }
};

template <int MODE> struct EpiOut {
    static constexpr int MID_T = -1;
    __device__ __forceinline__ void mid(f32x4 (&)[2][2][4][2], const pg8::Unit&, int, int, int, int) const {}
    const bf16_t* gate; float* tmp; bf16_t* merged; const float* x; float* out;
    __device__ __forceinline__ void operator()(const f32x4 (&acc)[2][2][4][2], const pg8::Unit& u, int wr, int wc, int fr_in, int fq_in) const {
        int fr = fr_in, fq = fq_in; asm volatile("" : "+v"(fr), "+v"(fq));
        const int row0 = u.pm * 256 + wr * 64 + fr, col0 = u.pn * 256 + wc * 32 + fq * 8;
        if (MODE == 2) {
            f32x4 xb[4][4];
#define EO_LOAD(it) do { const size_t _ro = (size_t)(row0 + ((it) >> 2) * 128 + ((it) & 3) * 16) * DM + col0; \
                xb[(it) & 3][0] = __builtin_nontemporal_load((const GAS f32x4*)(x + _ro)); xb[(it) & 3][1] = __builtin_nontemporal_load((const GAS f32x4*)(x + _ro + 4)); \
                xb[(it) & 3][2] = __builtin_nontemporal_load((const GAS f32x4*)(x + _ro + 128)); xb[(it) & 3][3] = __builtin_nontemporal_load((const GAS f32x4*)(x + _ro + 132)); } while (0)
            EO_LOAD(0); EO_LOAD(1); EO_LOAD(2);
#pragma unroll
            for (int it = 0; it < 8; ++it) {
                if (it + 3 < 8) EO_LOAD(it + 3);
                const int ai = it >> 2, m = it & 3;
                const size_t ro = (size_t)(row0 + ai * 128 + m * 16) * DM + col0;
                __builtin_nontemporal_store(xb[it & 3][0] + acc[ai][0][m][0], (GAS f32x4*)(out + ro)); __builtin_nontemporal_store(xb[it & 3][1] + acc[ai][0][m][1], (GAS f32x4*)(out + ro + 4));
                __builtin_nontemporal_store(xb[it & 3][2] + acc[ai][1][m][0], (GAS f32x4*)(out + ro + 128)); __builtin_nontemporal_store(xb[it & 3][3] + acc[ai][1][m][1], (GAS f32x4*)(out + ro + 132));
                __builtin_amdgcn_sched_barrier(0);
            }
#undef EO_LOAD
            return;
        }
#pragma unroll
        for (int ai = 0; ai < 2; ++ai)
#pragma unroll
            for (int m = 0; m < 4; ++m) {
                const size_t ro = (size_t)(row0 + ai * 128 + m * 16) * DM + col0;
#pragma unroll
                for (int bj = 0; bj < 2; ++bj) {
                    const size_t o = ro + bj * 128;
                    f32x4 a = acc[ai][bj][m][0], b = acc[ai][bj][m][1];
                    if (MODE == 2) {
                        const f32x4 xa = *(const GAS f32x4*)(x + o), xb = *(const GAS f32x4*)(x + o + 4);
                        *(GAS f32x4*)(out + o) = xa + a; *(GAS f32x4*)(out + o + 4) = xb + b;
                    } else {
                        const u32x4 gw = *(const GAS u32x4*)(gate + o);
                        a[0] *= bflo(gw.x); a[1] *= bfhi(gw.x); a[2] *= bflo(gw.y); a[3] *= bfhi(gw.y);
                        b[0] *= bflo(gw.z); b[1] *= bfhi(gw.z); b[2] *= bflo(gw.w); b[3] *= bfhi(gw.w);
                        if (MODE == 0) { *(GAS f32x4*)(tmp + o) = a; *(GAS f32x4*)(tmp + o + 4) = b; }
                        else { const f32x4 ta = *(const GAS f32x4*)(tmp + o), tb = *(const GAS f32x4*)(tmp + o + 4); a += ta; b += tb;
                            u32x4 w; w.x = cvt_pk_bf16(a[0], a[1]); w.y = cvt_pk_bf16(a[2], a[3]); w.z = cvt_pk_bf16(b[0], b[1]); w.w = cvt_pk_bf16(b[2], b[3]);
                            *(GAS u32x4*)(merged + o) = w; }
                    }
                }
                __builtin_amdgcn_sched_barrier(0);
            }
    }
};

struct EpiMerge {
    static constexpr int MID_T = 16;
    const bf16_t* ga; const bf16_t* gb; bf16_t* merged;
    __device__ __forceinline__ void mid(f32x4 (&acc)[2][2][4][2], const pg8::Unit& u, int wr, int wc, int fr_in, int fq_in) const {
        int fr = fr_in, fq = fq_in; asm volatile("" : "+v"(fr), "+v"(fq));
        const int row0 = u.pm * 256 + wr * 64 + fr, col0 = u.pn * 256 + wc * 32 + fq * 8;
        u32x4 ab[4][2], bb[4][2];
#define EM_LOAD(it) do { const size_t _ro = (size_t)(row0 + ((it) >> 2) * 128 + ((it) & 3) * 16) * DM + col0; \
            ab[(it) & 3][0] = *(const GAS u32x4*)(ga + _ro); ab[(it) & 3][1] = *(const GAS u32x4*)(ga + _ro + 128); \
            bb[(it) & 3][0] = *(const GAS u32x4*)(gb + _ro); bb[(it) & 3][1] = *(const GAS u32x4*)(gb + _ro + 128); } while (0)
        EM_LOAD(0); EM_LOAD(1); EM_LOAD(2);
#pragma unroll
        for (int it = 0; it < 8; ++it) {
            if (it + 3 < 8) EM_LOAD(it + 3);
            const int ai = it >> 2, m = it & 3;
#pragma unroll
            for (int bj = 0; bj < 2; ++bj) {
                const u32x4 a = ab[it & 3][bj], b = bb[it & 3][bj];
                f32x4& x = acc[ai][bj][m][0]; f32x4& y = acc[ai][bj][m][1];
                x[0] *= bflo(a.x) * __builtin_amdgcn_rcpf(fmaxf(bflo(b.x), 1e-30f)); x[1] *= bfhi(a.x) * __builtin_amdgcn_rcpf(fmaxf(bfhi(b.x), 1e-30f));
                x[2] *= bflo(a.y) * __builtin_amdgcn_rcpf(fmaxf(bflo(b.y), 1e-30f)); x[3] *= bfhi(a.y) * __builtin_amdgcn_rcpf(fmaxf(bfhi(b.y), 1e-30f));
                y[0] *= bflo(a.z) * __builtin_amdgcn_rcpf(fmaxf(bflo(b.z), 1e-30f)); y[1] *= bfhi(a.z) * __builtin_amdgcn_rcpf(fmaxf(bfhi(b.z), 1e-30f));
                y[2] *= bflo(a.w) * __builtin_amdgcn_rcpf(fmaxf(bflo(b.w), 1e-30f)); y[3] *= bfhi(a.w) * __builtin_amdgcn_rcpf(fmaxf(bfhi(b.w), 1e-30f));
            }
            __builtin_amdgcn_sched_barrier(0);
        }
#undef EM_LOAD
    }
    __device__ __forceinline__ void operator()(const f32x4 (&acc)[2][2][4][2], const pg8::Unit& u, int wr, int wc, int fr_in, int fq_in) const {
        int fr = fr_in, fq = fq_in; asm volatile("" : "+v"(fr), "+v"(fq));
        const int row0 = u.pm * 256 + wr * 64 + fr, col0 = u.pn * 256 + wc * 32 + fq * 8;
        u32x4 bb[4][2];
#define EM_LOAD(it) do { const size_t _ro = (size_t)(row0 + ((it) >> 2) * 128 + ((it) & 3) * 16) * DM + col0; \
            bb[(it) & 3][0] = *(const GAS u32x4*)(gb + _ro); bb[(it) & 3][1] = *(const GAS u32x4*)(gb + _ro + 128); } while (0)
        EM_LOAD(0); EM_LOAD(1); EM_LOAD(2);
#pragma unroll
        for (int it = 0; it < 8; ++it) {
            if (it + 3 < 8) EM_LOAD(it + 3);
            const int ai = it >> 2, m = it & 3;
            const size_t ro = (size_t)(row0 + ai * 128 + m * 16) * DM + col0;
#pragma unroll
            for (int bj = 0; bj < 2; ++bj) {
                const u32x4 b = bb[it & 3][bj];
                const f32x4 x = acc[ai][bj][m][0], y = acc[ai][bj][m][1];
                u32x4 w; w.x = cvt_pk_bf16(x[0] * bflo(b.x), x[1] * bfhi(b.x)); w.y = cvt_pk_bf16(x[2] * bflo(b.y), x[3] * bfhi(b.y));
                w.z = cvt_pk_bf16(y[0] * bflo(b.z), y[1] * bfhi(b.z)); w.w = cvt_pk_bf16(y[2] * bflo(b.w), y[3] * bfhi(b.w));
                *(GAS u32x4*)(merged + ro + bj * 128) = w;
            }
            __builtin_amdgcn_sched_barrier(0);
        }
#undef EM_LOAD
    }
};

__device__ __forceinline__ float score_bound_neg(const float* gq, const float* gk, int lane) {
    float a = fmaxf(fabsf(gq[lane]), fabsf(gq[lane + 64])), b = fmaxf(fabsf(gk[lane]), fabsf(gk[lane + 64]));
#pragma unroll
    for (int off = 32; off >= 1; off >>= 1) { a = fmaxf(a, __shfl_xor(a, off)); b = fmaxf(b, __shfl_xor(b, off)); }
    return -(128.0f * QSCALE * 1.02f) * a * b;
}
constexpr int KP = 272, VP = 320, KBYTES = 64 * KP, VBYTES = 64 * VP, ASTAGE = KBYTES + VBYTES;

template <int MODE>
__device__ void attn_block(LAS unsigned char* lds, const bf16_t* Qp, const bf16_t* Kp, const bf16_t* Vp, int qb, const unsigned* maskp, const bf16_t* sga, bf16_t* outp, const float negMB) {
    const int tid = opaque_tid(), wid = __builtin_amdgcn_readfirstlane(tid >> 6), lane = tid & 63, c = lane & 31, h = lane >> 5;
    const int grp = wid >> 2;
    const int q0 = qb * 256 + wid * 32, qpos = q0 + c;
    bf16x8 qf[8];
#pragma unroll
    for (int ks = 0; ks < 8; ++ks) qf[ks] = *(const GAS bf16x8*)(Qp + (size_t)qpos * 1024 + ks * 16 + h * 8);
    f32x16 o[4];
#pragma unroll
    for (int d = 0; d < 4; ++d)
#pragma unroll
        for (int r = 0; r < 16; ++r) o[d][r] = 0.f;
    float lrun = 0.f;
    const int nt = 4 * (qb + 1);
    const int my_last = (q0 + 31) >> 6;
    const int srow = tid >> 4, sch = tid & 15;
    u32x4 kr[2], vr[2];
    bf16x8 pf[2][2];
#pragma unroll
    for (int a = 0; a < 2; ++a)
#pragma unroll
        for (int b = 0; b < 2; ++b) pf[a][b] = (bf16x8){0, 0, 0, 0, 0, 0, 0, 0};
#define ATT_GLOAD(j) do { _Pragma("unroll") for (int _i = 0; _i < 2; ++_i) { const size_t _o = (size_t)((j) * 64 + srow + 32 * _i) * 1024 + sch * 8; \
        kr[_i] = *(const GAS u32x4*)(Kp + _o); vr[_i] = *(const GAS u32x4*)(Vp + _o); } } while (0)
#define ATT_LSTORE(buf) do { _Pragma("unroll") for (int _i = 0; _i < 2; ++_i) { \
        *(LAS u32x4*)(lds + (buf) * ASTAGE + (srow + 32 * _i) * KP + sch * 16) = kr[_i]; \
        *(LAS u32x4*)(lds + (buf) * ASTAGE + KBYTES + (srow + 32 * _i) * VP + sch * 16) = vr[_i]; } } while (0)
#define ATT_PV(stage) do { LAS unsigned char* _vb = lds + (stage) * ASTAGE + KBYTES; __builtin_amdgcn_s_setprio(1); \
        _Pragma("unroll") for (int st = 0; st < 2; ++st) _Pragma("unroll") for (int s2 = 0; s2 < 2; ++s2) _Pragma("unroll") for (int d = 0; d < 4; ++d) { \
            const s16x4 lo = __builtin_amdgcn_ds_read_tr16_b64_v4i16((LAS s16x4*)(_vb + vread + (32 * st + 16 * s2) * VP + d * 64)); \
            const s16x4 hi = __builtin_amdgcn_ds_read_tr16_b64_v4i16((LAS s16x4*)(_vb + vread + (32 * st + 16 * s2 + 8) * VP + d * 64)); \
            const bf16x8 vf = __builtin_shufflevector(lo, hi, 0, 1, 2, 3, 4, 5, 6, 7); \
            o[d] = __builtin_amdgcn_mfma_f32_32x32x16_bf16(vf, pf[st][s2], o[d], 0, 0, 0); } \
        __builtin_amdgcn_sched_group_barrier(0x100, 6, 1); \
        _Pragma("unroll") for (int i = 0; i < 16; ++i) { __builtin_amdgcn_sched_group_barrier(0x008, 1, 1); __builtin_amdgcn_sched_group_barrier(0x100, 2, 1); } \
        __builtin_amdgcn_s_setprio(0); } while (0)
    ATT_GLOAD(0); ATT_LSTORE(0);
    const int kread = c * KP + h * 16;
    const int vread = (4 * h + ((lane & 15) >> 2)) * VP + ((lane >> 4) & 1) * 32 + (lane & 3) * 8;
    u32x4 mw4 = {0u, 0u, 0u, 0u};
    int sj = 0, sp = 2;
    for (int j = 0; j < nt; ++j) {
        lds_barrier();
        const int sn = (sj == 2) ? 0 : sj + 1;
        if (j + 1 < nt) ATT_GLOAD(j + 1);
        u32x2 mw = {0u, 0u};
        if (MODE == 0) {
            if ((j & 1) == 0) { if (j <= my_last) mw4 = *(const GAS u32x4*)(maskp + ((size_t)(j >> 1) * SEQ + qpos) * 4); mw.x = mw4.x; mw.y = mw4.y; }
            else { mw.x = mw4.z; mw.y = mw4.w; }
        }
        if (grp == 1 && j >= 1 && j - 1 <= my_last) ATT_PV(sp);
        if (j <= my_last) {
            LAS unsigned char* kb = lds + sj * ASTAGE;
            f32x16 s0, s1;
#pragma unroll
            for (int r = 0; r < 16; ++r) { s0[r] = negMB; s1[r] = negMB; }
#pragma unroll
            for (int ks = 0; ks < 8; ++ks) {
                const bf16x8 k0 = *(const LAS bf16x8*)(kb + kread + ks * 32);
                const bf16x8 k1 = *(const LAS bf16x8*)(kb + kread + 32 * KP + ks * 32);
                s0 = __builtin_amdgcn_mfma_f32_32x32x16_bf16(k0, qf[ks], s0, 0, 0, 0);
                s1 = __builtin_amdgcn_mfma_f32_32x32x16_bf16(k1, qf[ks], s1, 0, 0, 0);
            }
            __builtin_amdgcn_sched_group_barrier(0x100, 6, 0);
#pragma unroll
            for (int i = 0; i < 8; ++i) { __builtin_amdgcn_sched_group_barrier(0x008, 2, 0); __builtin_amdgcn_sched_group_barrier(0x100, 2, 0); }
            if (j * 64 + 63 > q0) {
                const int kbase = j * 64 + 4 * h;
#pragma unroll
                for (int r = 0; r < 16; ++r) { const int key = kbase + (r & 3) + 8 * (r >> 2);
                    if (key > qpos) s0[r] = -INFINITY; if (key + 32 > qpos) s1[r] = -INFINITY; }
            }
#pragma unroll
            for (int r = 0; r < 16; ++r) { s0[r] = fast_exp2(s0[r]); s1[r] = fast_exp2(s1[r]); }
            if (MODE == 0) {
#pragma unroll
                for (int r = 0; r < 16; ++r) { const int bit = (r & 3) + 8 * (r >> 2) + 4 * h;
                    const int m0 = __builtin_amdgcn_sbfe((int)mw.x, bit, 1), m1 = __builtin_amdgcn_sbfe((int)mw.y, bit, 1);
                    s0[r] = __int_as_float(__float_as_int(s0[r]) & m0); s1[r] = __int_as_float(__float_as_int(s1[r]) & m1); }
            }
            float ls = 0.f;
#pragma unroll
            for (int r = 0; r < 16; ++r) ls += s0[r] + s1[r];
            lrun += ls;
#pragma unroll
            for (int s2 = 0; s2 < 2; ++s2) {
                u32x4 w0, w1;
                w0.x = cvt_pk_bf16(s0[8 * s2 + 0], s0[8 * s2 + 1]); w0.y = cvt_pk_bf16(s0[8 * s2 + 2], s0[8 * s2 + 3]); w0.z = cvt_pk_bf16(s0[8 * s2 + 4], s0[8 * s2 + 5]); w0.w = cvt_pk_bf16(s0[8 * s2 + 6], s0[8 * s2 + 7]);
                w1.x = cvt_pk_bf16(s1[8 * s2 + 0], s1[8 * s2 + 1]); w1.y = cvt_pk_bf16(s1[8 * s2 + 2], s1[8 * s2 + 3]); w1.z = cvt_pk_bf16(s1[8 * s2 + 4], s1[8 * s2 + 5]); w1.w = cvt_pk_bf16(s1[8 * s2 + 6], s1[8 * s2 + 7]);
                pf[0][s2] = __builtin_bit_cast(bf16x8, w0); pf[1][s2] = __builtin_bit_cast(bf16x8, w1);
            }
            if (grp == 0) ATT_PV(sj);
        }
        if (j + 1 < nt) ATT_LSTORE(sn);
        sp = sj; sj = sn;
    }
    if (grp == 1 && nt - 1 <= my_last) ATT_PV(sp);
#undef ATT_GLOAD
#undef ATT_LSTORE
#undef ATT_PV
    const float ltot = lrun + __shfl_xor(lrun, 32);
    const float inv = 1.0f / ltot;
#pragma unroll
    for (int d = 0; d < 4; ++d)
#pragma unroll
        for (int g = 0; g < 4; ++g) {
            const int dd = 32 * d + 8 * g + 4 * h;
            float v0 = o[d][4 * g] * inv, v1 = o[d][4 * g + 1] * inv, v2 = o[d][4 * g + 2] * inv, v3 = o[d][4 * g + 3] * inv;
            if (MODE == 0) {
                const u32x2 gw = *(const GAS u32x2*)(sga + (size_t)qpos * 1024 + dd);
                v0 *= bflo(gw.x); v1 *= bfhi(gw.x); v2 *= bflo(gw.y); v3 *= bfhi(gw.y);
                u32x2 w; w.x = cvt_pk_bf16(v0, v1); w.y = cvt_pk_bf16(v2, v3);
                *(GAS u32x2*)(outp + (size_t)qpos * 2048 + dd) = w;
            } else {
                u32x2 w; w.x = cvt_pk_bf16(v0, v1); w.y = cvt_pk_bf16(v2, v3);
                *(GAS u32x2*)(outp + (size_t)qpos * 2048 + dd) = w;
            }
        }
    __syncthreads();
}

constexpr int VP2 = 576, VB2 = 64 * VP2, PSTAGE = KBYTES + VB2  , XBUF_OFF = 2 * PSTAGE  ;
__device__ void attn_pair_block(LAS unsigned char* lds, const bf16_t* Qp, const bf16_t* Kp, const bf16_t* Vp, int qb, bf16_t* outp, const float negMB) {
    const int tid = opaque_tid(), wid = __builtin_amdgcn_readfirstlane(tid >> 6), lane = tid & 63, c = lane & 31, h = lane >> 5;
    const int stw = wid >> 2;
    const int q0 = qb * 128 + (wid & 3) * 32, qpos = q0 + c;
    bf16x8 qf[8];
#pragma unroll
    for (int ks = 0; ks < 8; ++ks) qf[ks] = *(const GAS bf16x8*)(Qp + (size_t)qpos * 1024 + ks * 16 + h * 8);
    f32x16 o[4];
#pragma unroll
    for (int d = 0; d < 4; ++d)
#pragma unroll
        for (int r = 0; r < 16; ++r) o[d][r] = 0.f;
    float lrun = 0.f;
    const int nt = 2 * (qb + 1);
    const int my_last = (q0 + 31) >> 6;
    u32x4 kr[2], vr[4];
#define PB_GLOAD(j) do { _Pragma("unroll") for (int _i = 0; _i < 2; ++_i) { const int _id = tid + 512 * _i; \
            kr[_i] = *(const GAS u32x4*)(Kp + (size_t)((j) * 64 + (_id >> 4)) * 1024 + (_id & 15) * 8); } \
        _Pragma("unroll") for (int _i = 0; _i < 4; ++_i) { const int _id = tid + 512 * _i; \
            vr[_i] = *(const GAS u32x4*)(Vp + (size_t)((j) * 64 + (_id >> 5)) * 1024 + (_id & 31) * 8); } } while (0)
#define PB_LSTORE(buf) do { _Pragma("unroll") for (int _i = 0; _i < 2; ++_i) { const int _id = tid + 512 * _i; \
            *(LAS u32x4*)(lds + (buf) * PSTAGE + (_id >> 4) * KP + (_id & 15) * 16) = kr[_i]; } \
        _Pragma("unroll") for (int _i = 0; _i < 4; ++_i) { const int _id = tid + 512 * _i; \
            *(LAS u32x4*)(lds + (buf) * PSTAGE + KBYTES + (_id >> 5) * VP2 + (_id & 31) * 16) = vr[_i]; } } while (0)
    PB_GLOAD(0); PB_LSTORE(0);
    __syncthreads();
    const int kread = (32 * stw + c) * KP + h * 16;
    const int vread = (4 * h + ((lane & 15) >> 2)) * VP2 + stw * 256 + ((lane >> 4) & 1) * 32 + (lane & 3) * 8;
    LAS unsigned char* xmine = lds + XBUF_OFF + wid * 2048 + lane * 16;
    const LAS unsigned char* xother = lds + XBUF_OFF + (wid ^ 4) * 2048 + lane * 16;
    for (int j = 0; j < nt; ++j) {
        LAS unsigned char* kb = lds + (j & 1) * PSTAGE; LAS unsigned char* vb = kb + KBYTES;
        if (j + 1 < nt) PB_GLOAD(j + 1);
        const bool act = j <= my_last;
        bf16x8 pown[2];
        if (act) {
            f32x16 s0;
#pragma unroll
            for (int r = 0; r < 16; ++r) s0[r] = negMB;
            __builtin_amdgcn_s_setprio(1);
#pragma unroll
            for (int ks = 0; ks < 8; ++ks) { const bf16x8 k0 = *(const LAS bf16x8*)(kb + kread + ks * 32); s0 = __builtin_amdgcn_mfma_f32_32x32x16_bf16(k0, qf[ks], s0, 0, 0, 0); }
            __builtin_amdgcn_sched_group_barrier(0x100, 3, 0);
#pragma unroll
            for (int i = 0; i < 8; ++i) { __builtin_amdgcn_sched_group_barrier(0x008, 1, 0); __builtin_amdgcn_sched_group_barrier(0x100, 1, 0); }
            __builtin_amdgcn_s_setprio(0);
            if (j * 64 + 63 > q0) {
                const int kbase = j * 64 + 32 * stw + 4 * h;
#pragma unroll
                for (int r = 0; r < 16; ++r) { const int key = kbase + (r & 3) + 8 * (r >> 2); if (key > qpos) s0[r] = -INFINITY; }
            }
#pragma unroll
            for (int r = 0; r < 16; ++r) s0[r] = fast_exp2(s0[r]);
            float ls = 0.f;
#pragma unroll
            for (int r = 0; r < 16; ++r) ls += s0[r];
            lrun += ls;
#pragma unroll
            for (int s2 = 0; s2 < 2; ++s2) { u32x4 w0;
                w0.x = cvt_pk_bf16(s0[8 * s2 + 0], s0[8 * s2 + 1]); w0.y = cvt_pk_bf16(s0[8 * s2 + 2], s0[8 * s2 + 3]); w0.z = cvt_pk_bf16(s0[8 * s2 + 4], s0[8 * s2 + 5]); w0.w = cvt_pk_bf16(s0[8 * s2 + 6], s0[8 * s2 + 7]);
                pown[s2] = __builtin_bit_cast(bf16x8, w0); *(LAS u32x4*)(xmine + s2 * 1024) = w0; }
        }
        lds_barrier();
        if (act) {
            bf16x8 poth[2];
#pragma unroll
            for (int s2 = 0; s2 < 2; ++s2) poth[s2] = *(const LAS bf16x8*)(xother + s2 * 1024);
            __builtin_amdgcn_s_setprio(1);
#pragma unroll
            for (int st = 0; st < 2; ++st)
#pragma unroll
                for (int s2 = 0; s2 < 2; ++s2)
#pragma unroll
                    for (int d = 0; d < 4; ++d) {
                        const s16x4 lo = __builtin_amdgcn_ds_read_tr16_b64_v4i16((LAS s16x4*)(vb + vread + (32 * st + 16 * s2) * VP2 + d * 64));
                        const s16x4 hi = __builtin_amdgcn_ds_read_tr16_b64_v4i16((LAS s16x4*)(vb + vread + (32 * st + 16 * s2 + 8) * VP2 + d * 64));
                        const bf16x8 vf = __builtin_shufflevector(lo, hi, 0, 1, 2, 3, 4, 5, 6, 7);
                        const bf16x8 pfr = (st == stw) ? pown[s2] : poth[s2];
                        o[d] = __builtin_amdgcn_mfma_f32_32x32x16_bf16(vf, pfr, o[d], 0, 0, 0);
                    }
            __builtin_amdgcn_sched_group_barrier(0x100, 8, 1);
#pragma unroll
            for (int i = 0; i < 16; ++i) { __builtin_amdgcn_sched_group_barrier(0x008, 1, 1); __builtin_amdgcn_sched_group_barrier(0x100, 2, 1); }
            __builtin_amdgcn_s_setprio(0);
        }
        if (j + 1 < nt) PB_LSTORE((j + 1) & 1);
        lds_barrier();
    }
#undef PB_GLOAD
#undef PB_LSTORE
    float lown = lrun + __shfl_xor(lrun, 32);
    *(LAS float*)(xmine) = lown;
    __syncthreads();
    const float ltot = lown + *(const LAS float*)(xother);
    const float inv = 1.0f / ltot;
#pragma unroll
    for (int d = 0; d < 4; ++d)
#pragma unroll
        for (int g = 0; g < 4; ++g) {
            const int dd = stw * 128 + 32 * d + 8 * g + 4 * h;
            u32x2 w; w.x = cvt_pk_bf16(o[d][4 * g] * inv, o[d][4 * g + 1] * inv); w.y = cvt_pk_bf16(o[d][4 * g + 2] * inv, o[d][4 * g + 3] * inv);
            *(GAS u32x2*)(outp + (size_t)qpos * 2048 + dd) = w;
        }
    __syncthreads();
}

constexpr int IX_QP = 2192  , IX_CAND = 16 * IX_QP  , IX_CNT = IX_CAND + 16 * 512 * 8  ;
__device__ __forceinline__ unsigned lds_add(LAS unsigned* p, unsigned v) { return __hip_atomic_fetch_add(p, v, __ATOMIC_RELAXED, __HIP_MEMORY_SCOPE_WORKGROUP); }
__device__ __forceinline__ void lds_or(LAS unsigned* p, unsigned v) { __hip_atomic_fetch_or(p, v, __ATOMIC_RELAXED, __HIP_MEMORY_SCOPE_WORKGROUP); }
__device__ __forceinline__ unsigned f2key(float x) { const unsigned u = __float_as_uint(x); return (u & 0x80000000u) ? ~u : (u | 0x80000000u); }

template <bool EXACT>
__device__ void select256(LAS unsigned char* lds, int qi, int wid, int lane) {
    LAS u64* cand = (LAS u64*)(lds + IX_CAND) + qi * 512;
    LAS unsigned* cnt = (LAS unsigned*)(lds + IX_CNT);
    const int m = min((int)cnt[qi], 512);
    u64 e[8]; unsigned k[8];
#pragma unroll
    for (int i = 0; i < 8; ++i) { const int idx = lane + 64 * i; e[i] = idx < m ? cand[idx] : 0ull; k[i] = (unsigned)(e[i] >> 16); }
    unsigned T = 0u;
    int cT = m;
#pragma unroll 1
    for (int bit = 31; bit >= 0; --bit) {
        const unsigned trial = T | (1u << bit);
        int c = 0;
#pragma unroll
        for (int i = 0; i < 8; ++i) c += __builtin_popcountll(__ballot(k[i] >= trial));
        if (c >= 256) { T = trial; cT = c; }
        if (!EXACT && cT <= 320) break;
    }
    if (!EXACT) {
        int base = 0;
#pragma unroll
        for (int i = 0; i < 8; ++i) {
            const bool keep = k[i] >= T;
            const u64 bm = __ballot(keep);
            const int pos = base + __builtin_popcountll(bm & ((1ull << lane) - 1ull));
            if (keep) cand[pos] = e[i];
            base += __builtin_popcountll(bm);
        }
        if (lane == 0) { cnt[qi] = (unsigned)base; cnt[32 + qi] = T - 1u; }
        return;
    }
    int g = 0, eq = 0;
#pragma unroll
    for (int i = 0; i < 8; ++i) { g += __builtin_popcountll(__ballot(k[i] > T)); eq += __builtin_popcountll(__ballot(k[i] == T)); }
    const int needeq = 256 - g;
    unsigned L = 0u;
    if (eq > needeq) {
#pragma unroll 1
        for (int bit = 15; bit >= 0; --bit) {
            const unsigned trial = L | (1u << bit);
            int c = 0;
#pragma unroll
            for (int i = 0; i < 8; ++i) c += __builtin_popcountll(__ballot(k[i] == T && (unsigned)(e[i] & 0xFFFFull) >= trial));
            if (c >= needeq) L = trial;
        }
    }
    const u64 thr = ((u64)T << 16) | (u64)L;
    int base = 0;
#pragma unroll
    for (int i = 0; i < 8; ++i) {
        const bool keep = e[i] >= thr;
        const u64 bm = __ballot(keep);
        const int pos = base + __builtin_popcountll(bm & ((1ull << lane) - 1ull));
        if (keep) cand[pos] = e[i];
        base += __builtin_popcountll(bm);
    }
    if (lane == 0) { cnt[qi] = 256u; cnt[32 + qi] = T; }
}

__device__ void indexer_item(LAS unsigned char* lds, const bf16_t* Qi, const bf16_t* Ki, const float* Wi, unsigned* maskout, int qt) {
    const int tid = opaque_tid(), wid = __builtin_amdgcn_readfirstlane(tid >> 6), lane = tid & 63, q = lane & 15, quad = lane >> 4;
    const int t0 = qt * 16;
    LAS unsigned* cnt = (LAS unsigned*)(lds + IX_CNT);
    LAS u64* cand = (LAS u64*)(lds + IX_CAND);
#pragma unroll
    for (int i = 0; i < 4; ++i) { const int id = tid + 512 * i, row = id >> 7, ch = id & 127;
        *(LAS u32x4*)(lds + row * IX_QP + ch * 16) = *(const GAS u32x4*)(Qi + (size_t)(t0 + row) * 1024 + ch * 8); }
    if (tid < 64) cnt[tid] = 0u;
    float wv[16];
#pragma unroll
    for (int i = 0; i < 4; ++i) { const f32x4 w4 = *(const GAS f32x4*)(Wi + (size_t)(t0 + q) * 16 + i * 4); wv[4 * i] = 0.5f * w4[0]; wv[4 * i + 1] = 0.5f * w4[1]; wv[4 * i + 2] = 0.5f * w4[2]; wv[4 * i + 3] = 0.5f * w4[3]; }
    f32x4 wq[4];
#pragma unroll
    for (int i = 0; i < 4; ++i) wq[i] = *(const GAS f32x4*)(Wi + (size_t)(t0 + (tid >> 5)) * 16 + i * 4);
    bf16x8 kn[2][2];
#pragma unroll
    for (int st = 0; st < 2; ++st)
#pragma unroll
        for (int ks = 0; ks < 2; ++ks) kn[st][ks] = *(const GAS bf16x8*)(Ki + (size_t)(wid * 32 + 16 * st + q) * 64 + ks * 32 + quad * 8);
    __syncthreads();
    {
        const int qr = tid >> 5, dp = tid & 31;
        float e0 = 0.f, e1 = 0.f;
#pragma unroll
        for (int i = 0; i < 4; ++i) { const f32x4 w4 = wq[i];
#pragma unroll
            for (int jj = 0; jj < 4; ++jj) { const unsigned v = *(const LAS unsigned*)(lds + qr * IX_QP + (4 * i + jj) * 128 + dp * 4); e0 += w4[jj] * bflo(v); e1 += w4[jj] * bfhi(v); } }
        *(LAS unsigned*)(lds + qr * IX_QP + 16 * 128 + dp * 4) = cvt_pk_bf16(0.5f * e0, 0.5f * e1);
    }
    __syncthreads();
    const int niter = (t0 + 16 + 255) >> 8;
    const int tq = t0 + q;
    const LAS unsigned char* qrow = lds + q * IX_QP + quad * 16;
    unsigned thr = 0u;
    for (int it = 0; it < niter; ++it) {
        const int kb = it * 256 + wid * 32;
        bf16x8 kf[2][2];
#pragma unroll
        for (int st = 0; st < 2; ++st)
#pragma unroll
            for (int ks = 0; ks < 2; ++ks) kf[st][ks] = kn[st][ks];
        { const int itn = (it + 1 < niter) ? it + 1 : it; const int kbn = itn * 256 + wid * 32;
#pragma unroll
          for (int st = 0; st < 2; ++st)
#pragma unroll
            for (int ks = 0; ks < 2; ++ks) kn[st][ks] = *(const GAS bf16x8*)(Ki + (size_t)(kbn + 16 * st + q) * 64 + ks * 32 + quad * 8); }
        const f32x4 z4 = {0.f, 0.f, 0.f, 0.f};
        f32x4 sc0, sc1, c0, c1;
        { const bf16x8 qa = *(const LAS bf16x8*)(qrow + 16 * 128), qb2 = *(const LAS bf16x8*)(qrow + 16 * 128 + 64);
          sc0 = __builtin_amdgcn_mfma_f32_16x16x32_bf16(kf[0][0], qa, z4, 0, 0, 0); sc0 = __builtin_amdgcn_mfma_f32_16x16x32_bf16(kf[0][1], qb2, sc0, 0, 0, 0);
          sc1 = __builtin_amdgcn_mfma_f32_16x16x32_bf16(kf[1][0], qa, z4, 0, 0, 0); sc1 = __builtin_amdgcn_mfma_f32_16x16x32_bf16(kf[1][1], qb2, sc1, 0, 0, 0); }
        { const bf16x8 qa = *(const LAS bf16x8*)(qrow), qb2 = *(const LAS bf16x8*)(qrow + 64);
          c0 = __builtin_amdgcn_mfma_f32_16x16x32_bf16(kf[0][0], qa, z4, 0, 0, 0); c0 = __builtin_amdgcn_mfma_f32_16x16x32_bf16(kf[0][1], qb2, c0, 0, 0, 0);
          c1 = __builtin_amdgcn_mfma_f32_16x16x32_bf16(kf[1][0], qa, z4, 0, 0, 0); c1 = __builtin_amdgcn_mfma_f32_16x16x32_bf16(kf[1][1], qb2, c1, 0, 0, 0); }
#pragma unroll
        for (int hd = 0; hd < 16; ++hd) {
            f32x4 n0 = z4, n1 = z4;
            if (hd < 15) {
                const bf16x8 qa = *(const LAS bf16x8*)(qrow + (hd + 1) * 128), qb2 = *(const LAS bf16x8*)(qrow + (hd + 1) * 128 + 64);
                n0 = __builtin_amdgcn_mfma_f32_16x16x32_bf16(kf[0][0], qa, z4, 0, 0, 0); n0 = __builtin_amdgcn_mfma_f32_16x16x32_bf16(kf[0][1], qb2, n0, 0, 0, 0);
                n1 = __builtin_amdgcn_mfma_f32_16x16x32_bf16(kf[1][0], qa, z4, 0, 0, 0); n1 = __builtin_amdgcn_mfma_f32_16x16x32_bf16(kf[1][1], qb2, n1, 0, 0, 0);
            }
            if (hd < 15)
                asm volatile("v_fma_f32 %0, %16, |%8|, %0\n\tv_fma_f32 %1, %16, |%9|, %1\n\tv_fma_f32 %2, %16, |%10|, %2\n\tv_fma_f32 %3, %16, |%11|, %3\n\t"
                             "v_fma_f32 %4, %16, |%12|, %4\n\tv_fma_f32 %5, %16, |%13|, %5\n\tv_fma_f32 %6, %16, |%14|, %6\n\tv_fma_f32 %7, %16, |%15|, %7"
                             : "+v"(sc0[0]), "+v"(sc0[1]), "+v"(sc0[2]), "+v"(sc0[3]), "+v"(sc1[0]), "+v"(sc1[1]), "+v"(sc1[2]), "+v"(sc1[3])
                             : "v"(c0[0]), "v"(c0[1]), "v"(c0[2]), "v"(c0[3]), "v"(c1[0]), "v"(c1[1]), "v"(c1[2]), "v"(c1[3]), "v"(wv[hd]), "v"(n0), "v"(n1));
            else
                asm volatile("s_nop 15\n\ts_nop 15\n\t"
                             "v_fma_f32 %0, %16, |%8|, %0\n\tv_fma_f32 %1, %16, |%9|, %1\n\tv_fma_f32 %2, %16, |%10|, %2\n\tv_fma_f32 %3, %16, |%11|, %3\n\t"
                             "v_fma_f32 %4, %16, |%12|, %4\n\tv_fma_f32 %5, %16, |%13|, %5\n\tv_fma_f32 %6, %16, |%14|, %6\n\tv_fma_f32 %7, %16, |%15|, %7"
                             : "+v"(sc0[0]), "+v"(sc0[1]), "+v"(sc0[2]), "+v"(sc0[3]), "+v"(sc1[0]), "+v"(sc1[1]), "+v"(sc1[2]), "+v"(sc1[3])
                             : "v"(c0[0]), "v"(c0[1]), "v"(c0[2]), "v"(c0[3]), "v"(c1[0]), "v"(c1[1]), "v"(c1[2]), "v"(c1[3]), "v"(wv[hd]));
            c0 = n0; c1 = n1;
        }
        unsigned k32[8]; int keyi[8];
#pragma unroll
        for (int j = 0; j < 4; ++j) { k32[j] = f2key(sc0[j]); k32[4 + j] = f2key(sc1[j]); keyi[j] = kb + quad * 4 + j; keyi[4 + j] = kb + 16 + quad * 4 + j; }
        int np = 0;
#pragma unroll
        for (int j = 0; j < 8; ++j) np += (keyi[j] <= tq && k32[j] > thr) ? 1 : 0;
        const int cnoff = (it & 1) ? 48 : 16;
        if (np) lds_add(cnt + cnoff + q, (unsigned)np);
        lds_barrier();
        bool round;
        {
            const unsigned both = (lane < 16) ? cnt[lane] + cnt[cnoff + lane] : 0u;
            if (tid < 16) cnt[(cnoff ^ 32) + tid] = 0u;
            round = __ballot(both > 512u) != 0ull;
            if (round) {
#pragma unroll 1
                for (int qq = 0; qq < 2; ++qq) { const int qi = 2 * wid + qq; const unsigned cc = cnt[qi], cn = cnt[cnoff + qi];
                    if (cc + cn > 512u || cc > 320u) {
                        if (cn > 192u || cc <= 320u) select256<true>(lds, qi, wid, lane); else select256<false>(lds, qi, wid, lane); } }
            }
        }
        lds_barrier();
        if (round) thr = cnt[32 + q];
#pragma unroll
        for (int j = 0; j < 8; ++j) if (keyi[j] <= tq && k32[j] > thr) {
            const unsigned pos = lds_add(cnt + q, 1u);
            if (pos < 512u) cand[q * 512 + pos] = ((u64)k32[j] << 16) | (u64)(16383 - keyi[j]);
        }
    }
    __syncthreads();
#pragma unroll 1
    for (int qq = 0; qq < 2; ++qq) { const int qi = 2 * wid + qq; if (cnt[qi] > 256u) select256<true>(lds, qi, wid, lane); }
    __syncthreads();
    LAS unsigned* rows = (LAS unsigned*)lds;
#pragma unroll
    for (int i = 0; i < 4; ++i) *(LAS u32x4*)(rows + (tid + 512 * i) * 4) = (u32x4){0u, 0u, 0u, 0u};
    __syncthreads();
#pragma unroll 1
    for (int qq = 0; qq < 2; ++qq) { const int qi = 2 * wid + qq; const int n = min((int)cnt[qi], 256);
        for (int e = lane; e < n; e += 64) { const u64 ent = cand[qi * 512 + e]; const int key = 16383 - (int)(ent & 0xFFFFull);
            lds_or(rows + qi * 512 + (key >> 5), 1u << (key & 31)); } }
    __syncthreads();
#pragma unroll
    for (int i = 0; i < 4; ++i) { const int id = tid + 512 * i, row = id & 15, jp = id >> 4;
        *(GAS u32x4*)(maskout + ((size_t)jp * SEQ + t0 + row) * 4) = *(const LAS u32x4*)(rows + row * 512 + jp * 4); }
    __syncthreads();
}

__device__ void combine_b(const Params& p) {
    const int tid = opaque_tid(), wid = tid >> 6, lane = tid & 63;
    float s1 = p.lq1[lane] * p.lk1[lane] + p.lq1[lane + 64] * p.lk1[lane + 64];
    float s2 = p.lq2[lane] * p.lk2[lane] + p.lq2[lane + 64] * p.lk2[lane + 64];
#pragma unroll
    for (int o = 32; o >= 1; o >>= 1) { s1 += __shfl_xor(s1, o); s2 += __shfl_xor(s2, o); }
    const float lam = expf(s1) - expf(s2) + 0.2f;
    const bf16_t* ob = (const bf16_t*)((unsigned char*)p.out + DO_OB);
    const bf16_t* sgb = (const bf16_t*)(p.ws + WS_SGB);
    bf16_t* ub = (bf16_t*)(p.ws + WS_UA) + 1024;
    const f32x4 g = *(const GAS f32x4*)(p.subln + lane * 4);
    const int gw = blockIdx.x * 8 + wid, nw = gridDim.x * 8;
    for (int n = gw; n < NTOK; n += nw) {
        u32x2 a[4], b[4], gt[4];
#pragma unroll
        for (int hb = 0; hb < 4; ++hb) {
            a[hb] = *(const GAS u32x2*)(ob + (size_t)n * 2048 + (hb * 2) * 256 + lane * 4);
            b[hb] = *(const GAS u32x2*)(ob + (size_t)n * 2048 + (hb * 2 + 1) * 256 + lane * 4);
            gt[hb] = *(const GAS u32x2*)(sgb + (size_t)n * 1024 + hb * 256 + lane * 4); }
        float v[4][4], ss[4];
#pragma unroll
        for (int hb = 0; hb < 4; ++hb) {
            v[hb][0] = bflo(a[hb].x) - lam * bflo(b[hb].x); v[hb][1] = bfhi(a[hb].x) - lam * bfhi(b[hb].x);
            v[hb][2] = bflo(a[hb].y) - lam * bflo(b[hb].y); v[hb][3] = bfhi(a[hb].y) - lam * bfhi(b[hb].y);
            ss[hb] = v[hb][0] * v[hb][0] + v[hb][1] * v[hb][1] + v[hb][2] * v[hb][2] + v[hb][3] * v[hb][3]; }
#pragma unroll
        for (int o = 32; o >= 1; o >>= 1) {
#pragma unroll
            for (int hb = 0; hb < 4; ++hb) ss[hb] += __shfl_xor(ss[hb], o); }
#pragma unroll
        for (int hb = 0; hb < 4; ++hb) {
            const float r = rsqrtf(ss[hb] * (1.0f / 256.f) + 1e-5f) * 0.8f;
            u32x2 w; w.x = cvt_pk_bf16(v[hb][0] * r * g[0] * bflo(gt[hb].x), v[hb][1] * r * g[1] * bfhi(gt[hb].x));
            w.y = cvt_pk_bf16(v[hb][2] * r * g[2] * bflo(gt[hb].y), v[hb][3] * r * g[3] * bfhi(gt[hb].y));
            *(GAS u32x2*)(ub + (size_t)n * 2048 + hb * 256 + lane * 4) = w; }
    }
}

__global__ void __launch_bounds__(512, 2) mega(Params p_unused) {
    KQ kp = (KQ)__builtin_amdgcn_kernarg_segment_ptr();
    extern __shared__ __attribute__((aligned(16))) unsigned char lds_raw[];
    LAS unsigned char* lds = (LAS unsigned char*)lds_raw;
    cg::grid_group grid = cg::this_grid();
    LAS int* item_slot = (LAS int*)(lds + ITEM_OFF);

    if (blockIdx.x == 0 && threadIdx.x < 64) ((unsigned*)load_params(kp).ws)[threadIdx.x] = 0u;
#ifndef SKIP_P0
    { const Params p = load_params(kp); prep_phase(p, lds); }
#endif
    grid.sync();
#ifndef SKIP_P1
    {
        const Params p = load_params(kp); unsigned char* dout = (unsigned char*)p.out;
        pg8::Gemm g{(const bf16_t*)(dout + DO_H), (const bf16_t*)(p.ws + WS_WINT), NTOK, NP, DM};
        pg8::StaticOrder S; S.init(NTOK, NP, gridDim.x, blockIdx.x);
        EpiIn E{p.ws, (const float*)(dout + DO_COSA), (const float*)(dout + DO_SINA), (const float*)(dout + DO_COSI), (const float*)(dout + DO_SINI),
                p.a_q_gain, p.a_k_gain, p.b_q_gain, p.b_k_gain, (LAS float*)(lds + 131072)};
        pg8::gemm_phase(lds, g, S, E);
    }
#endif
    grid.sync();
#define FETCH_ITEM(base, nitems) do { \
        __syncthreads(); \
        if (tid == 0) { int it, k = xk; for (;;) { const int qx = (xcd + k) & 7; it = (int)atomicAdd(ctr + (base) + qx, 1u); \
                if (it < (nitems)) { it |= qx << 16; break; } if (++k == 8) { it = -1; break; } } \
            item_slot[0] = it; item_slot[1] = k; } \
        __syncthreads(); \
        item = item_slot[0]; xk = item_slot[1]; } while (0)
#ifndef SKIP_P2
    { int xk = 0; const int xcd = blockIdx.x & 7;
    float negMB_b; { const Params p0 = load_params(kp); negMB_b = score_bound_neg(p0.b_q_gain, p0.b_k_gain, threadIdx.x & 63); }
    for (;;) {
        const Params p = load_params(kp); unsigned char* dout = (unsigned char*)p.out; unsigned* ctr = (unsigned*)(p.ws + WS_CTR); const int tid = opaque_tid();
        int item;
        FETCH_ITEM(0, 512);
        if (item < 0) break;
        const int qx = item >> 16, n = item & 0xFFFF;
        if (n < 256) {
            const int qb = 127 - (n >> 1), map = n & 1, b = qx & 1, hb = qx >> 1;
            const size_t tok0 = (size_t)b * SEQ;
            const bf16_t* Q = (const bf16_t*)(p.ws + WS_QB) + tok0 * 1024 + (hb * 2 + map) * 128;
            const bf16_t* K = (const bf16_t*)(p.ws + WS_KB) + tok0 * 1024 + (hb * 2 + map) * 128;
            const bf16_t* V = (const bf16_t*)(p.ws + WS_VB) + tok0 * 1024 + hb * 256;
            bf16_t* O = (bf16_t*)(dout + DO_OB) + tok0 * 2048 + (hb * 2 + map) * 256;
            attn_pair_block(lds, Q, K, V, qb, O, negMB_b);
        } else {
            const int i2 = (n - 256) * 8 + qx, qt = 1023 - (i2 >> 1), b = i2 & 1;
            const size_t tok0 = (size_t)b * SEQ;
            indexer_item(lds, (const bf16_t*)(p.ws + WS_QI) + tok0 * 1024, (const bf16_t*)(p.ws + WS_KI) + tok0 * 64, (const float*)(p.ws + WS_WI) + tok0 * 16,
                         (unsigned*)(dout + DO_MASK) + tok0 * 512, qt);
        }
    } }
#endif
    grid.sync();
#ifndef SKIP_P3
    { const Params p = load_params(kp); combine_b(p); }
    { int xk = 0; const int xcd = blockIdx.x & 7;
    float negMB_a; { const Params p0 = load_params(kp); negMB_a = score_bound_neg(p0.a_q_gain, p0.a_k_gain, threadIdx.x & 63); }
    for (;;) {
        const Params p = load_params(kp); unsigned char* dout = (unsigned char*)p.out; unsigned* ctr = (unsigned*)(p.ws + WS_CTR); const int tid = opaque_tid();
        int item;
        FETCH_ITEM(8, 128);
        if (item < 0) break;
        const int qx = item >> 16, n = item & 0xFFFF;
        const int qb = 63 - (n >> 1), idx = qx + 8 * (n & 1), b = idx & 1, hd = idx >> 1;
        const size_t tok0 = (size_t)b * SEQ;
        attn_block<0>(lds, (const bf16_t*)(p.ws + WS_QA) + tok0 * 1024 + hd * 128, (const bf16_t*)(p.ws + WS_KA) + tok0 * 1024 + hd * 128,
                      (const bf16_t*)(p.ws + WS_VA) + tok0 * 1024 + hd * 128, qb, (const unsigned*)(dout + DO_MASK) + tok0 * 512,
                      (const bf16_t*)(p.ws + WS_SGA) + tok0 * 1024 + hd * 128, (bf16_t*)(p.ws + WS_UA) + tok0 * 2048 + hd * 128, negMB_a);
    } }
#endif
#undef FETCH_ITEM
    grid.sync();
#ifndef SKIP_P4
    {
        const Params p = load_params(kp);
        pg8::StaticOrder S; S.init(NTOK, DM, gridDim.x, blockIdx.x);
        pg8::Gemm gab{(const bf16_t*)(p.ws + WS_UA), (const bf16_t*)(p.ws + WS_WOAT), NTOK, DM, DM};
        EpiMerge Em{(const bf16_t*)(p.ws + WS_SMA), (const bf16_t*)(p.ws + WS_SMB), (bf16_t*)(p.ws + WS_MERGED)};
        pg8::gemm_phase(lds, gab, S, Em);
    }
#endif
    grid.sync();
#ifndef SKIP_P5
    {
        const Params p = load_params(kp);
        pg8::StaticOrder S; S.init(NTOK, DM, gridDim.x, blockIdx.x);
        pg8::Gemm go{(const bf16_t*)(p.ws + WS_MERGED), (const bf16_t*)(p.ws + WS_WOUTT), NTOK, DM, DM};
        EpiOut<2> Eo{nullptr, nullptr, nullptr, p.x, p.out};
        pg8::gemm_phase(lds, go, S, Eo);
    }
#endif
}

extern "C" void kernel_launch(void* const* d_in, const int* in_sizes, int n_in, void* d_out, int out_size, void* d_ws, size_t ws_size, hipStream_t stream) {
    static int grid_blocks = 0;
    if (!grid_blocks) {
        hipFuncSetAttribute((const void*)mega, hipFuncAttributeMaxDynamicSharedMemorySize, LDS_BYTES);
        int dev = 0, cus = 0, per_cu = 0;
        hipGetDevice(&dev);
        hipDeviceGetAttribute(&cus, hipDeviceAttributeMultiprocessorCount, dev);
        hipOccupancyMaxActiveBlocksPerMultiprocessor(&per_cu, mega, 512, LDS_BYTES);
        if (per_cu < 1) per_cu = 1;
        grid_blocks = cus * 1;
    }
    Params p{};
    p.x = (const float*)d_in[0]; p.pos = (const int*)d_in[1]; p.norm_gain = (const float*)d_in[2]; p.w_in = (const float*)d_in[3];
    p.a_q_gain = (const float*)d_in[4]; p.a_k_gain = (const float*)d_in[5]; p.b_q_gain = (const float*)d_in[6]; p.b_k_gain = (const float*)d_in[7];
    p.lq1 = (const float*)d_in[8]; p.lk1 = (const float*)d_in[9]; p.lq2 = (const float*)d_in[10]; p.lk2 = (const float*)d_in[11]; p.subln = (const float*)d_in[12];
    p.w_o_a = (const float*)d_in[13]; p.w_o_b = (const float*)d_in[14]; p.w_out = (const float*)d_in[15];
    p.out = (float*)d_out; p.ws = (unsigned char*)d_ws;
    void* args[] = {&p};
    hipError_t e = hipLaunchCooperativeKernel((void*)mega, dim3(grid_blocks), dim3(512), args, LDS_BYTES, stream);
    if (e != hipSuccess) fprintf(stderr, "cooperative launch failed: %s (grid %d)\n", hipGetErrorString(e), grid_blocks);
}
```

```cpp
#include <hip/hip_runtime.h>
#include <hip/hip_cooperative_groups.h>
#include <cstdio>
#include <cstdint>
namespace cg = cooperative_groups;

#define LAS __attribute__((address_space(3)))
#define GAS __attribute__((address_space(1)))
typedef unsigned short bf16_t;
typedef short bf16x8 __attribute__((ext_vector_type(8)));
typedef short s16x4 __attribute__((ext_vector_type(4)));
typedef float f32x4 __attribute__((ext_vector_type(4)));
typedef float f32x16 __attribute__((ext_vector_type(16)));
typedef unsigned u32x4 __attribute__((ext_vector_type(4)));
typedef unsigned u32x2 __attribute__((ext_vector_type(2)));
typedef unsigned long long u64;

constexpr int SEQ = 16384, NTOK = 32768, DM = 2048, INC = 13392, NP = 13568;
constexpr int LDS_BYTES = 131072 + 8192 + 64;
constexpr int ITEM_OFF = 131072 + 8192;
constexpr float QSCALE = 0.08838834764831845f * 1.4426950408889634f;

struct Params {
    const float* x; const int* pos; const float* norm_gain; const float* w_in;
    const float* a_q_gain; const float* a_k_gain; const float* b_q_gain; const float* b_k_gain;
    const float* lq1; const float* lk1; const float* lq2; const float* lk2; const float* subln;
    const float* w_o_a; const float* w_o_b; const float* w_out;
    float* out; unsigned char* ws;
};

typedef const __attribute__((address_space(4))) unsigned long long* KQ;
__device__ __forceinline__ Params load_params(KQ kq) {
    asm volatile("" : "+s"(kq));
    Params p;
    p.x = (const float*)kq[0]; p.pos = (const int*)kq[1]; p.norm_gain = (const float*)kq[2]; p.w_in = (const float*)kq[3];
    p.a_q_gain = (const float*)kq[4]; p.a_k_gain = (const float*)kq[5]; p.b_q_gain = (const float*)kq[6]; p.b_k_gain = (const float*)kq[7];
    p.lq1 = (const float*)kq[8]; p.lk1 = (const float*)kq[9]; p.lq2 = (const float*)kq[10]; p.lk2 = (const float*)kq[11]; p.subln = (const float*)kq[12];
    p.w_o_a = (const float*)kq[13]; p.w_o_b = (const float*)kq[14]; p.w_out = (const float*)kq[15];
    p.out = (float*)kq[16]; p.ws = (unsigned char*)kq[17];
    return p;
}

constexpr size_t MiB = 1u << 20;
constexpr size_t WS_CTR = 0;
constexpr size_t WS_WINT = 1 * MiB;
constexpr size_t WS_WOAT = 54 * MiB, WS_WOBT = 58 * MiB, WS_WOUTT = 62 * MiB;
constexpr size_t WS_QA = 70 * MiB, WS_KA = 134 * MiB, WS_VA = 198 * MiB, WS_SGA = 262 * MiB;
constexpr size_t WS_QI = 326 * MiB, WS_KI = 390 * MiB, WS_WI = 394 * MiB;
constexpr size_t WS_QB = 396 * MiB, WS_KB = 460 * MiB, WS_VB = 524 * MiB, WS_SGB = 588 * MiB;
constexpr size_t WS_SMA = 652 * MiB, WS_SMB = 780 * MiB;
constexpr size_t WS_UA = WS_QB, WS_UB = WS_KB;
constexpr size_t WS_MERGED = WS_QA;
constexpr size_t DO_H = 0, DO_OB = 0, DO_MASK = 128 * MiB, DO_COSA = 192 * MiB, DO_SINA = 200 * MiB, DO_COSI = 208 * MiB, DO_SINI = 212 * MiB;

__device__ __forceinline__ unsigned cvt_pk_bf16(float lo, float hi) { unsigned r; asm volatile("v_cvt_pk_bf16_f32 %0, %1, %2" : "=v"(r) : "v"(lo), "v"(hi)); return r; }
__device__ __forceinline__ float bf2f(unsigned short b) { return __uint_as_float(((unsigned)b) << 16); }
__device__ __forceinline__ float bflo(unsigned w) { return __uint_as_float(w << 16); }
__device__ __forceinline__ float bfhi(unsigned w) { return __uint_as_float(w & 0xffff0000u); }
__device__ __forceinline__ float fast_exp2(float x) { return __builtin_amdgcn_exp2f(x); }
__device__ __forceinline__ float sigmoidf_(float x) { return __builtin_amdgcn_rcpf(1.0f + __builtin_amdgcn_exp2f(-1.4426950408889634f * x)); }

__device__ __forceinline__ void lds_barrier() { asm volatile("s_waitcnt lgkmcnt(0)" ::: "memory"); __builtin_amdgcn_s_barrier(); asm volatile("" ::: "memory"); }
__device__ __forceinline__ int opaque_tid() { int t = threadIdx.x; asm volatile("" : "+v"(t)); return t; }

__device__ __forceinline__ int orig_col(int c) {
    if (c < 4096) { int seg = c >> 10, w = c & 1023; if (seg < 2) { int hd = w >> 7, p = w & 127; w = hd * 128 + (p & 1) * 64 + (p >> 1); } return seg * 1024 + w; }
    if (c < 5120) { int w = c - 4096; int hd = w >> 6, p = w & 63; return 4096 + hd * 64 + (p & 1) * 32 + (p >> 1); }
    if (c < 9216) { int w0 = c - 5120; int seg = w0 >> 10, w = w0 & 1023; if (seg < 2) { int hd = w >> 7, p = w & 127; w = hd * 128 + (p & 1) * 64 + (p >> 1); } return 5200 + seg * 1024 + w; }
    if (c < 13312) return 9296 + (c - 9216);
    int w = c - 13312;
    if (w < 64) return 5120 + (w & 1) * 32 + (w >> 1);
    if (w < 80) return 5184 + (w - 64);
    return -1;
}

template <bool MAPPED>
__device__ void transpose_convert(LAS unsigned char* lds, const float* src, int src_ld, int K, int ncols, bf16_t* dst, int dst_ld, int k_off, int tile0, int tstride) {
    LAS float* tile = (LAS float*)lds;
    const int tid = opaque_tid(), ktiles = K / 256, ntiles = (ncols / 64) * ktiles;
    for (int t = tile0; t < ntiles; t += tstride) {
        const int ct = t / ktiles, kt = t % ktiles, c0 = ct * 64, k0 = kt * 256;
        const int i = tid & 63, j = tid >> 6;
        const int oc = MAPPED ? orig_col(c0 + i) : (c0 + i);
        float v[32];
#pragma unroll
        for (int kk = 0; kk < 32; ++kk) v[kk] = (oc >= 0) ? __builtin_nontemporal_load((const GAS float*)(src + (size_t)(k0 + j + 8 * kk) * src_ld + oc)) : 0.f;
#pragma unroll
        for (int kk = 0; kk < 32; ++kk) tile[(j + 8 * kk) * 65 + i] = v[kk];
        __syncthreads();
#pragma unroll
        for (int u = 0; u < 4; ++u) {
            const int id = tid + 512 * u, q = ((id >> 8) << 2) | (id & 3), r = (id >> 2) & 63;
            u32x4 w;
            w.x = cvt_pk_bf16(tile[(q * 8 + 0) * 65 + r], tile[(q * 8 + 1) * 65 + r]); w.y = cvt_pk_bf16(tile[(q * 8 + 2) * 65 + r], tile[(q * 8 + 3) * 65 + r]);
            w.z = cvt_pk_bf16(tile[(q * 8 + 4) * 65 + r], tile[(q * 8 + 5) * 65 + r]); w.w = cvt_pk_bf16(tile[(q * 8 + 6) * 65 + r], tile[(q * 8 + 7) * 65 + r]);
            *(GAS u32x4*)(dst + (size_t)(c0 + r) * dst_ld + k_off + k0 + q * 8) = w;
        }
        __syncthreads();
    }
}

__device__ void prep_phase(const Params& p, LAS unsigned char* lds) {
    const int tid = opaque_tid(), wid = tid >> 6, lane = tid & 63;
    unsigned char* dout = (unsigned char*)p.out;
    {
        bf16_t* H = (bf16_t*)(dout + DO_H);
        const int gw = blockIdx.x * 8 + wid, nw = gridDim.x * 8;
        for (int n0 = gw; n0 < NTOK; n0 += 2 * nw) {
            const int n1 = n0 + nw;
            const float* xr0 = p.x + (size_t)n0 * DM; const float* xr1 = p.x + (size_t)n1 * DM;
            f32x4 v0[8], v1[8]; float s0 = 0.f, s1 = 0.f;
#pragma unroll
            for (int i = 0; i < 8; ++i) { v0[i] = __builtin_nontemporal_load((const GAS f32x4*)(xr0 + i * 256 + lane * 4)); v1[i] = __builtin_nontemporal_load((const GAS f32x4*)(xr1 + i * 256 + lane * 4)); }
#pragma unroll
            for (int i = 0; i < 8; ++i) { s0 += v0[i][0] * v0[i][0] + v0[i][1] * v0[i][1] + v0[i][2] * v0[i][2] + v0[i][3] * v0[i][3];
                                          s1 += v1[i][0] * v1[i][0] + v1[i][1] * v1[i][1] + v1[i][2] * v1[i][2] + v1[i][3] * v1[i][3]; }
#pragma unroll
            for (int o = 32; o >= 1; o >>= 1) { s0 += __shfl_xor(s0, o); s1 += __shfl_xor(s1, o); }
            const float r0 = rsqrtf(s0 * (1.0f / DM) + 1e-6f), r1 = rsqrtf(s1 * (1.0f / DM) + 1e-6f);
#pragma unroll
            for (int i = 0; i < 8; ++i) { const f32x4 g = *(const GAS f32x4*)(p.norm_gain + i * 256 + lane * 4);
                u32x2 w; w.x = cvt_pk_bf16(v0[i][0] * r0 * g[0], v0[i][1] * r0 * g[1]); w.y = cvt_pk_bf16(v0[i][2] * r0 * g[2], v0[i][3] * r0 * g[3]);
                *(GAS u32x2*)(H + (size_t)n0 * DM + i * 256 + lane * 4) = w;
                u32x2 w2; w2.x = cvt_pk_bf16(v1[i][0] * r1 * g[0], v1[i][1] * r1 * g[1]); w2.y = cvt_pk_bf16(v1[i][2] * r1 * g[2], v1[i][3] * r1 * g[3]);
                *(GAS u32x2*)(H + (size_t)n1 * DM + i * 256 + lane * 4) = w2; }
        }
    }
    {
        float* cosA = (float*)(dout + DO_COSA); float* sinA = (float*)(dout + DO_SINA); float* cosI = (float*)(dout + DO_COSI); float* sinI = (float*)(dout + DO_SINI);
        LAS float* invf = (LAS float*)(lds + 32768);
        if (tid < 64) invf[tid] = (float)pow(10000.0, -(double)(2 * tid) / 128.0);
        else if (tid < 96) invf[tid] = (float)pow(10000.0, -(double)(2 * (tid - 64)) / 64.0);
        __syncthreads();
        const int gt = blockIdx.x * 512 + tid, nthr = gridDim.x * 512;
        for (int e = gt; e < NTOK * 96; e += nthr) {
            const int n = e / 96, i = e % 96;
            const float a = (float)p.pos[n] * invf[i];
            float sv, cv; sincosf(a, &sv, &cv);
            if (i < 64) { cosA[(size_t)n * 64 + i] = cv; sinA[(size_t)n * 64 + i] = sv; }
            else { cosI[(size_t)n * 32 + (i - 64)] = cv; sinI[(size_t)n * 32 + (i - 64)] = sv; }
        }
        __syncthreads();
    }
    transpose_convert<true>(lds, p.w_in, INC, DM, NP, (bf16_t*)(p.ws + WS_WINT), DM, 0, blockIdx.x, gridDim.x);
    transpose_convert<false>(lds, p.w_o_a, DM, 1024, DM, (bf16_t*)(p.ws + WS_WOAT), DM, 0, blockIdx.x, gridDim.x);
    transpose_convert<false>(lds, p.w_o_b, DM, 1024, DM, (bf16_t*)(p.ws + WS_WOAT), DM, 1024, blockIdx.x, gridDim.x);
    transpose_convert<false>(lds, p.w_out, DM, DM, DM, (bf16_t*)(p.ws + WS_WOUTT), DM, 0, blockIdx.x, gridDim.x);
}

namespace pg8 {
constexpr int BM = 256, BK = 64, HALF = 128, HTB = HALF * BK * 2, STAGE_BYTES = 8 * HTB, NXCD = 8, WGM = 8;
__device__ __forceinline__ int lds_byte(int r, int c) { const int st = (r >> 4) * 2 + (c >> 5), rr = r & 15, cc = c & 31, ob = rr * 64 + cc * 2; return st * 1024 + (ob ^ (((ob >> 9) & 1) << 5)); }
__device__ __forceinline__ void stage_rc(int b, int& R, int& C) { const int st = b / 1024, sb = b % 1024, swz = sb ^ (((sb >> 9) & 1) << 5); R = (st >> 1) * 16 + swz / 64; C = (st & 1) * 32 + (swz % 64) / 2; }
__device__ __forceinline__ int perm32(int rho) { const int n = rho >> 4, i = rho & 15; return 8 * (i >> 2) + 4 * n + (i & 3); }
struct Unit { int pm, pn; };
struct Gemm { const bf16_t* A; const bf16_t* Bt; int M, N, K; };
struct StaticOrder {
    int nM, nN, nwg, G, c;
    __device__ void init(int M, int N, int G_, int c_) { nM = M / BM; nN = N / BM; nwg = nM * nN; G = G_; c = c_; }
    __device__ bool next(int i, Unit& u) const {
        const long L = (long)i * G + c; if (L >= nwg) return false;
        int wgid = (int)L; { const int q = nwg / NXCD, r = nwg % NXCD, xcd = wgid % NXCD, off = wgid / NXCD; wgid = (xcd < r ? xcd * (q + 1) : r * (q + 1) + (xcd - r) * q) + off; }
        const int nig = WGM * nN, gid = wgid / nig, fm = gid * WGM, gsz = (nM - fm) < WGM ? (nM - fm) : WGM;
        u.pm = fm + ((wgid % nig) % gsz); u.pn = (wgid % nig) / gsz; return true;
    }
};

template <class Epi>
__device__ __forceinline__ void gemm_phase(LAS unsigned char* lds, const Gemm g, const StaticOrder& S, const Epi& E) {
    const int tid = opaque_tid(), wid = __builtin_amdgcn_readfirstlane(tid >> 6), lane = tid & 63, wr = wid >> 2, wc = wid & 3, fr = lane & 15, fq = lane >> 4;
    const int K = g.K, nt = K / BK;
    unsigned voffA[2], voffB[2];
#pragma unroll
    for (int i = 0; i < 2; ++i) { int R, C; stage_rc(tid * 16 + i * 8192, R, C); const int Rb = (R & ~31) + perm32(R & 31);
        voffA[i] = (unsigned)(R * K + C) * 2u; voffB[i] = (unsigned)(Rb * K + C) * 2u; }
    const size_t kstep = (size_t)(BK * 2);
    const size_t hstep = (size_t)HALF * K * 2;
    const size_t tstep = 2 * hstep;
    const unsigned ldsw = (unsigned)wid * 1024u;
    const int aoff = lds_byte(wr * 64 + fr, fq * 8), boff = lds_byte(wc * 32 + fr, fq * 8);
#define PG8_SA(b, h) (((b) * 2 + (h)) * HTB)
#define PG8_SB(b, h) ((4 + (b) * 2 + (h)) * HTB)
#define PG8_STAGE(bufoff, gbase, voff) do { _Pragma("unroll") for (int _i = 0; _i < 2; ++_i) \
        __builtin_amdgcn_global_load_lds((const unsigned*)((const char*)(gbase) + (voff)[_i]), (LAS unsigned*)(lds + (bufoff) + ldsw + _i * 8192), 16, 0, 0); } while (0)
#define PG8_LDA(dst, b, h) do { _Pragma("unroll") for (int m = 0; m < 4; ++m) _Pragma("unroll") for (int k = 0; k < 2; ++k) dst[m][k] = *(const LAS bf16x8*)(lds + PG8_SA(b, h) + aoff + m * 2048 + k * 1024); } while (0)
#define PG8_LDB(dst, b, h) do { _Pragma("unroll") for (int n = 0; n < 2; ++n) _Pragma("unroll") for (int k = 0; k < 2; ++k) dst[n][k] = *(const LAS bf16x8*)(lds + PG8_SB(b, h) + boff + n * 2048 + k * 1024); } while (0)
#define PG8_MMA(ai, bj, At, Bt) do { __builtin_amdgcn_s_setprio(1); _Pragma("unroll") for (int m = 0; m < 4; ++m) _Pragma("unroll") for (int n = 0; n < 2; ++n) _Pragma("unroll") for (int k = 0; k < 2; ++k) \
        acc[ai][bj][m][n] = __builtin_amdgcn_mfma_f32_16x16x32_bf16(Bt[n][k], At[m][k], acc[ai][bj][m][n], 0, 0, 0); __builtin_amdgcn_s_setprio(0); } while (0)
#define PG8_WAIT_V(n) asm volatile("s_waitcnt vmcnt(" #n ")" ::: "memory")
#define PG8_WAIT_L(n) asm volatile("s_waitcnt lgkmcnt(" #n ")" ::: "memory")
#define PG8_BAR __builtin_amdgcn_s_barrier()
#define PG8_SCHED __builtin_amdgcn_sched_barrier(0)
    Unit cur, nxt; int ui = 0;
    if (!S.next(0, cur)) return;
    f32x4 acc[2][2][4][2];
#pragma unroll
    for (int a = 0; a < 2; ++a)
#pragma unroll
        for (int b = 0; b < 2; ++b)
#pragma unroll
            for (int m = 0; m < 4; ++m)
#pragma unroll
                for (int n = 0; n < 2; ++n) acc[a][b][m][n] = (f32x4){0.f, 0.f, 0.f, 0.f};
    bf16x8 At[4][2], B0[2][2], B1[2][2];
    const char* cA = (const char*)g.A + (size_t)cur.pm * tstep; const char* cB = (const char*)g.Bt + (size_t)cur.pn * tstep;
    PG8_STAGE(PG8_SB(0, 0), cB, voffB); PG8_STAGE(PG8_SA(0, 0), cA, voffA); PG8_STAGE(PG8_SB(0, 1), cB + hstep, voffB); PG8_STAGE(PG8_SA(0, 1), cA + hstep, voffA);
    if (wr == 1) PG8_BAR;
    PG8_WAIT_V(4); PG8_BAR;
    PG8_STAGE(PG8_SB(1, 0), cB + kstep, voffB); PG8_STAGE(PG8_SA(1, 0), cA + kstep, voffA); PG8_STAGE(PG8_SB(1, 1), cB + hstep + kstep, voffB);
    PG8_WAIT_V(6); PG8_BAR;
    for (;;) {
        const bool has_next = S.next(ui + 1, nxt);
        const char* nA = has_next ? (const char*)g.A + (size_t)nxt.pm * tstep : cA; const char* nB = has_next ? (const char*)g.Bt + (size_t)nxt.pn * tstep : cB;
        for (int t = 0; t < nt; t += 2) {
            if (Epi::MID_T >= 0 && t == Epi::MID_T) E.mid(acc, cur, wr, wc, fr, fq);
            const bool last = (t == nt - 2);
            const char* a1 = cA + (size_t)(t + 1) * kstep;
            const char* a2 = last ? nA : cA + (size_t)(t + 2) * kstep; const char* b2 = last ? nB : cB + (size_t)(t + 2) * kstep;
            const char* a3 = a2 + kstep; const char* b3 = b2 + kstep;
            PG8_LDB(B0, 0, 0); PG8_SCHED; PG8_LDA(At, 0, 0); PG8_STAGE(PG8_SA(1, 1), a1 + hstep, voffA);
            PG8_WAIT_L(8); PG8_BAR; PG8_WAIT_L(0); PG8_MMA(0, 0, At, B0); PG8_BAR; PG8_SCHED;
            PG8_LDB(B1, 0, 1); PG8_STAGE(PG8_SB(0, 0), b2, voffB);
            PG8_BAR; PG8_WAIT_L(0); PG8_MMA(0, 1, At, B1); PG8_BAR;
            PG8_LDA(At, 0, 1); PG8_STAGE(PG8_SA(0, 0), a2, voffA);
            PG8_BAR; PG8_WAIT_L(0); PG8_MMA(1, 0, At, B0); PG8_BAR; PG8_SCHED;
            PG8_STAGE(PG8_SB(0, 1), b2 + hstep, voffB);
            PG8_WAIT_V(6); PG8_BAR; PG8_MMA(1, 1, At, B1); PG8_BAR;
            PG8_LDB(B0, 1, 0); PG8_SCHED; PG8_LDA(At, 1, 0); PG8_STAGE(PG8_SA(0, 1), a2 + hstep, voffA);
            PG8_WAIT_L(8); PG8_BAR; PG8_WAIT_L(0); PG8_MMA(0, 0, At, B0); PG8_BAR; PG8_SCHED;
            PG8_LDB(B1, 1, 1); PG8_STAGE(PG8_SB(1, 0), b3, voffB);
            PG8_BAR; PG8_WAIT_L(0); PG8_MMA(0, 1, At, B1); PG8_BAR;
            PG8_LDA(At, 1, 1); PG8_STAGE(PG8_SA(1, 0), a3, voffA);
            PG8_BAR; PG8_WAIT_L(0); PG8_MMA(1, 0, At, B0); PG8_BAR; PG8_SCHED;
            PG8_STAGE(PG8_SB(1, 1), b3 + hstep, voffB);
            PG8_WAIT_V(6); PG8_BAR; PG8_MMA(1, 1, At, B1); PG8_BAR;
        }
        E(acc, cur, wr, wc, fr, fq);
        if (!has_next) break;
#pragma unroll
        for (int a = 0; a < 2; ++a)
#pragma unroll
            for (int b = 0; b < 2; ++b)
#pragma unroll
                for (int m = 0; m < 4; ++m)
#pragma unroll
                    for (int n = 0; n < 2; ++n) acc[a][b][m][n] = (f32x4){0.f, 0.f, 0.f, 0.f};
        cur = nxt; cA = nA; cB = nB; ++ui;
    }
    PG8_WAIT_V(0);
    if (wr == 0) PG8_BAR;
    PG8_BAR;
#undef PG8_SA
#undef PG8_SB
#undef PG8_STAGE
#undef PG8_LDA
#undef PG8_LDB
#undef PG8_MMA
#undef PG8_WAIT_V
#undef PG8_WAIT_L
#undef PG8_SCHED
}
}

struct EpiIn {
    static constexpr int MID_T = -1;
    __device__ __forceinline__ void mid(f32x4 (&)[2][2][4][2], const pg8::Unit&, int, int, int, int) const {}
    unsigned char* ws; const float* cosA; const float* sinA; const float* cosI; const float* sinI;
    const float* gaq; const float* gak; const float* gbq; const float* gbk;
    LAS float* red;
    __device__ __forceinline__ void operator()(const f32x4 (&acc)[2][2][4][2], const pg8::Unit& u, int wr, int wc, int fr_in, int fq_in) const {
        int fr = fr_in, fq = fq_in; asm volatile("" : "+v"(fr), "+v"(fq));
        const int pn = u.pn;
        const int row0 = u.pm * 256 + wr * 64 + fr;
        const int cw = wc * 32 + fq * 8;
        int mode; bf16_t* dst; int ldc = 1024, colbase; const float* gain = nullptr; float qs = 1.f;
        if (pn < 16) { const int seg = pn >> 2; colbase = (pn & 3) * 256;
            dst = (bf16_t*)(ws + (seg == 0 ? WS_QA : seg == 1 ? WS_KA : seg == 2 ? WS_VA : WS_SGA));
            mode = seg < 2 ? 4 : (seg == 2 ? 0 : 1); gain = seg == 0 ? gaq : gak; qs = seg == 0 ? QSCALE : 1.f; }
        else if (pn < 20) { colbase = (pn - 16) * 256; dst = (bf16_t*)(ws + WS_QI); mode = 3; }
        else if (pn < 36) { const int seg = (pn - 20) >> 2; colbase = ((pn - 20) & 3) * 256;
            dst = (bf16_t*)(ws + (seg == 0 ? WS_QB : seg == 1 ? WS_KB : seg == 2 ? WS_VB : WS_SGB));
            mode = seg < 2 ? 4 : (seg == 2 ? 0 : 1); gain = seg == 0 ? gbq : gbk; qs = seg == 0 ? QSCALE : 1.f; }
        else if (pn < 44) { colbase = (pn - 36) * 256; dst = (bf16_t*)(ws + WS_SMA); ldc = 2048; mode = 2; }
        else if (pn < 52) { colbase = (pn - 44) * 256; dst = (bf16_t*)(ws + WS_SMB); ldc = 2048; mode = 2; }
        else { colbase = 0; dst = (bf16_t*)(ws + WS_KI); ldc = 64; mode = 5; }

        if (mode == 4) {
            LAS float* redw = red + ((wr * 64 + fr) * 2) * 4 + wc;
            const LAS float* redr = red + ((wr * 64 + fr) * 2) * 4;
#pragma unroll
            for (int ai = 0; ai < 2; ++ai)
#pragma unroll
                for (int m = 0; m < 4; ++m)
#pragma unroll
                    for (int bj = 0; bj < 2; ++bj) {
                        const f32x4 a = acc[ai][bj][m][0], b = acc[ai][bj][m][1];
                        float ss = a[0] * a[0] + a[1] * a[1] + a[2] * a[2] + a[3] * a[3] + b[0] * b[0] + b[1] * b[1] + b[2] * b[2] + b[3] * b[3];
                        ss += __shfl_xor(ss, 16); ss += __shfl_xor(ss, 32);
                        if (fq == 0) redw[((ai * 128 + m * 16) * 2 + bj) * 4] = ss;
                        __builtin_amdgcn_sched_barrier(0);
                    }
            asm volatile("s_waitcnt lgkmcnt(0)" ::: "memory");
            __builtin_amdgcn_s_barrier();
            const int pi0 = cw >> 1;
            const f32x4 g1 = *(const GAS f32x4*)(gain + pi0), g2 = *(const GAS f32x4*)(gain + 64 + pi0);
#pragma unroll
            for (int ai = 0; ai < 2; ++ai)
#pragma unroll
                for (int m = 0; m < 4; ++m) {
                    const int rl = ai * 128 + wr * 64 + m * 16 + fr; const int row = u.pm * 256 + rl;
                    const f32x4 cs = *(const GAS f32x4*)(cosA + (size_t)row * 64 + pi0), sn = *(const GAS f32x4*)(sinA + (size_t)row * 64 + pi0);
#pragma unroll
                    for (int bj = 0; bj < 2; ++bj) {
                        const f32x4 r4 = *(const LAS f32x4*)(redr + ((ai * 128 + m * 16) * 2 + bj) * 4);
                        const float inv = rsqrtf((r4[0] + r4[1] + r4[2] + r4[3]) * (1.0f / 128.f) + 1e-6f) * qs;
                        const f32x4 a = acc[ai][bj][m][0], b = acc[ai][bj][m][1];
                        const float x1a = a[0] * inv * g1[0], x2a = a[1] * inv * g2[0], x1b = a[2] * inv * g1[1], x2b = a[3] * inv * g2[1];
                        const float x1c = b[0] * inv * g1[2], x2c = b[1] * inv * g2[2], x1d = b[2] * inv * g1[3], x2d = b[3] * inv * g2[3];
                        u32x4 w;
                        w.x = cvt_pk_bf16(x1a * cs[0] - x2a * sn[0], x2a * cs[0] + x1a * sn[0]);
                        w.y = cvt_pk_bf16(x1b * cs[1] - x2b * sn[1], x2b * cs[1] + x1b * sn[1]);
                        w.z = cvt_pk_bf16(x1c * cs[2] - x2c * sn[2], x2c * cs[2] + x1c * sn[2]);
                        w.w = cvt_pk_bf16(x1d * cs[3] - x2d * sn[3], x2d * cs[3] + x1d * sn[3]);
                        __builtin_nontemporal_store(w, (GAS u32x4*)(dst + (size_t)row * ldc + colbase + bj * 128 + cw));
                    }
                    __builtin_amdgcn_sched_barrier(0);
                }
            return;
        }
        if (mode == 3 || mode == 5) {
            const int pi0 = (cw & 63) >> 1;
#pragma unroll
            for (int ai = 0; ai < 2; ++ai)
#pragma unroll
                for (int m = 0; m < 4; ++m) {
                    const int row = row0 + ai * 128 + m * 16;
                    const f32x4 cs = *(const GAS f32x4*)(cosI + (size_t)row * 32 + pi0), sn = *(const GAS f32x4*)(sinI + (size_t)row * 32 + pi0);
#pragma unroll
                    for (int bj = 0; bj < 2; ++bj) {
                        const f32x4 a = acc[ai][bj][m][0], b = acc[ai][bj][m][1];
                        if (mode == 5) {
                            if (bj == 1 || wc == 3) continue;
                            if (wc == 2) { if (fq < 2) { float* wi = (float*)(ws + WS_WI) + (size_t)row * 16 + fq * 8;
                                    *(GAS f32x4*)wi = a * 0.03125f; *(GAS f32x4*)(wi + 4) = b * 0.03125f; }
                                continue; }
                        }
                        u32x4 w;
                        w.x = cvt_pk_bf16(a[0] * cs[0] - a[1] * sn[0], a[1] * cs[0] + a[0] * sn[0]);
                        w.y = cvt_pk_bf16(a[2] * cs[1] - a[3] * sn[1], a[3] * cs[1] + a[2] * sn[1]);
                        w.z = cvt_pk_bf16(b[0] * cs[2] - b[1] * sn[2], b[1] * cs[2] + b[0] * sn[2]);
                        w.w = cvt_pk_bf16(b[2] * cs[3] - b[3] * sn[3], b[3] * cs[3] + b[2] * sn[3]);
                        __builtin_nontemporal_store(w, (GAS u32x4*)(dst + (size_t)row * ldc + colbase + bj * 128 + cw));
                    }
                    __builtin_amdgcn_sched_barrier(0);
                }
            return;
        }
#pragma unroll
        for (int ai = 0; ai < 2; ++ai)
#pragma unroll
            for (int m = 0; m < 4; ++m) {
                const int row = row0 + ai * 128 + m * 16;
#pragma unroll
                for (int bj = 0; bj < 2; ++bj) {
                    f32x4 a = acc[ai][bj][m][0], b = acc[ai][bj][m][1];
                    if (mode == 1) {
#pragma unroll
                        for (int j = 0; j < 4; ++j) { a[j] = a[j] * sigmoidf_(a[j]); b[j] = b[j] * sigmoidf_(b[j]); } }
                    else if (mode == 2) {
#pragma unroll
                        for (int j = 0; j < 4; ++j) { a[j] = sigmoidf_(a[j]); b[j] = sigmoidf_(b[j]); } }
                    u32x4 w; w.x = cvt_pk_bf16(a[0], a[1]); w.y = cvt_pk_bf16(a[2], a[3]); w.z = cvt_pk_bf16(b[0], b[1]); w.w = cvt_pk_bf16(b[2], b[3]);
                    __builtin_nontemporal_store(w, (GAS u32x4*)(dst + (size_t)row * ldc + colbase + bj * 128 + cw));
                }
                __builtin_amdgcn_sched_barrier(0);
            }
    }
};

template <int MODE> struct EpiOut {
    static constexpr int MID_T = -1;
    __device__ __forceinline__ void mid(f32x4 (&)[2][2][4][2], const pg8::Unit&, int, int, int, int) const {}
    const bf16_t* gate; float* tmp; bf16_t* merged; const float* x; float* out;
    __device__ __forceinline__ void operator()(const f32x4 (&acc)[2][2][4][2], const pg8::Unit& u, int wr, int wc, int fr_in, int fq_in) const {
        int fr = fr_in, fq = fq_in; asm volatile("" : "+v"(fr), "+v"(fq));
        const int row0 = u.pm * 256 + wr * 64 + fr, col0 = u.pn * 256 + wc * 32 + fq * 8;
        if (MODE == 2) {
            f32x4 xb[4][4];
#define EO_LOAD(it) do { const size_t _ro = (size_t)(row0 + ((it) >> 2) * 128 + ((it) & 3) * 16) * DM + col0; \
                xb[(it) & 3][0] = __builtin_nontemporal_load((const GAS f32x4*)(x + _ro)); xb[(it) & 3][1] = __builtin_nontemporal_load((const GAS f32x4*)(x + _ro + 4)); \
                xb[(it) & 3][2] = __builtin_nontemporal_load((const GAS f32x4*)(x + _ro + 128)); xb[(it) & 3][3] = __builtin_nontemporal_load((const GAS f32x4*)(x + _ro + 132)); } while (0)
            EO_LOAD(0); EO_LOAD(1); EO_LOAD(2);
#pragma unroll
            for (int it = 0; it < 8; ++it) {
                if (it + 3 < 8) EO_LOAD(it + 3);
                const int ai = it >> 2, m = it & 3;
                const size_t ro = (size_t)(row0 + ai * 128 + m * 16) * DM + col0;
                __builtin_nontemporal_store(xb[it & 3][0] + acc[ai][0][m][0], (GAS f32x4*)(out + ro)); __builtin_nontemporal_store(xb[it & 3][1] + acc[ai][0][m][1], (GAS f32x4*)(out + ro + 4));
                __builtin_nontemporal_store(xb[it & 3][2] + acc[ai][1][m][0], (GAS f32x4*)(out + ro + 128)); __builtin_nontemporal_store(xb[it & 3][3] + acc[ai][1][m][1], (GAS f32x4*)(out + ro + 132));
                __builtin_amdgcn_sched_barrier(0);
            }
#undef EO_LOAD
            return;
        }
#pragma unroll
        for (int ai = 0; ai < 2; ++ai)
#pragma unroll
            for (int m = 0; m < 4; ++m) {
                const size_t ro = (size_t)(row0 + ai * 128 + m * 16) * DM + col0;
#pragma unroll
                for (int bj = 0; bj < 2; ++bj) {
                    const size_t o = ro + bj * 128;
                    f32x4 a = acc[ai][bj][m][0], b = acc[ai][bj][m][1];
                    if (MODE == 2) {
                        const f32x4 xa = *(const GAS f32x4*)(x + o), xb = *(const GAS f32x4*)(x + o + 4);
                        *(GAS f32x4*)(out + o) = xa + a; *(GAS f32x4*)(out + o + 4) = xb + b;
                    } else {
                        const u32x4 gw = *(const GAS u32x4*)(gate + o);
                        a[0] *= bflo(gw.x); a[1] *= bfhi(gw.x); a[2] *= bflo(gw.y); a[3] *= bfhi(gw.y);
                        b[0] *= bflo(gw.z); b[1] *= bfhi(gw.z); b[2] *= bflo(gw.w); b[3] *= bfhi(gw.w);
                        if (MODE == 0) { *(GAS f32x4*)(tmp + o) = a; *(GAS f32x4*)(tmp + o + 4) = b; }
                        else { const f32x4 ta = *(const GAS f32x4*)(tmp + o), tb = *(const GAS f32x4*)(tmp + o + 4); a += ta; b += tb;
                            u32x4 w; w.x = cvt_pk_bf16(a[0], a[1]); w.y = cvt_pk_bf16(a[2], a[3]); w.z = cvt_pk_bf16(b[0], b[1]); w.w = cvt_pk_bf16(b[2], b[3]);
                            *(GAS u32x4*)(merged + o) = w; }
                    }
                }
                __builtin_amdgcn_sched_barrier(0);
            }
    }
};

struct EpiMerge {
    static constexpr int MID_T = 16;
    const bf16_t* ga; const bf16_t* gb; bf16_t* merged;
    __device__ __forceinline__ void mid(f32x4 (&acc)[2][2][4][2], const pg8::Unit& u, int wr, int wc, int fr_in, int fq_in) const {
        int fr = fr_in, fq = fq_in; asm volatile("" : "+v"(fr), "+v"(fq));
        const int row0 = u.pm * 256 + wr * 64 + fr, col0 = u.pn * 256 + wc * 32 + fq * 8;
        u32x4 ab[4][2], bb[4][2];
#define EM_LOAD(it) do { const size_t _ro = (size_t)(row0 + ((it) >> 2) * 128 + ((it) & 3) * 16) * DM + col0; \
            ab[(it) & 3][0] = *(const GAS u32x4*)(ga + _ro); ab[(it) & 3][1] = *(const GAS u32x4*)(ga + _ro + 128); \
            bb[(it) & 3][0] = *(const GAS u32x4*)(gb + _ro); bb[(it) & 3][1] = *(const GAS u32x4*)(gb + _ro + 128); } while (0)
        EM_LOAD(0); EM_LOAD(1); EM_LOAD(2);
#pragma unroll
        for (int it = 0; it < 8; ++it) {
            if (it + 3 < 8) EM_LOAD(it + 3);
            const int ai = it >> 2, m = it & 3;
#pragma unroll
            for (int bj = 0; bj < 2; ++bj) {
                const u32x4 a = ab[it & 3][bj], b = bb[it & 3][bj];
                f32x4& x = acc[ai][bj][m][0]; f32x4& y = acc[ai][bj][m][1];
                x[0] *= bflo(a.x) * __builtin_amdgcn_rcpf(fmaxf(bflo(b.x), 1e-30f)); x[1] *= bfhi(a.x) * __builtin_amdgcn_rcpf(fmaxf(bfhi(b.x), 1e-30f));
                x[2] *= bflo(a.y) * __builtin_amdgcn_rcpf(fmaxf(bflo(b.y), 1e-30f)); x[3] *= bfhi(a.y) * __builtin_amdgcn_rcpf(fmaxf(bfhi(b.y), 1e-30f));
                y[0] *= bflo(a.z) * __builtin_amdgcn_rcpf(fmaxf(bflo(b.z), 1e-30f)); y[1] *= bfhi(a.z) * __builtin_amdgcn_rcpf(fmaxf(bfhi(b.z), 1e-30f));
                y[2] *= bflo(a.w) * __builtin_amdgcn_rcpf(fmaxf(bflo(b.w), 1e-30f)); y[3] *= bfhi(a.w) * __builtin_amdgcn_rcpf(fmaxf(bfhi(b.w), 1e-30f));
            }
            __builtin_amdgcn_sched_barrier(0);
        }
#undef EM_LOAD
    }
    __device__ __forceinline__ void operator()(const f32x4 (&acc)[2][2][4][2], const pg8::Unit& u, int wr, int wc, int fr_in, int fq_in) const {
        int fr = fr_in, fq = fq_in; asm volatile("" : "+v"(fr), "+v"(fq));
        const int row0 = u.pm * 256 + wr * 64 + fr, col0 = u.pn * 256 + wc * 32 + fq * 8;
        u32x4 bb[4][2];
#define EM_LOAD(it) do { const size_t _ro = (size_t)(row0 + ((it) >> 2) * 128 + ((it) & 3) * 16) * DM + col0; \
            bb[(it) & 3][0] = *(const GAS u32x4*)(gb + _ro); bb[(it) & 3][1] = *(const GAS u32x4*)(gb + _ro + 128); } while (0)
        EM_LOAD(0); EM_LOAD(1); EM_LOAD(2);
#pragma unroll
        for (int it = 0; it < 8; ++it) {
            if (it + 3 < 8) EM_LOAD(it + 3);
            const int ai = it >> 2, m = it & 3;
            const size_t ro = (size_t)(row0 + ai * 128 + m * 16) * DM + col0;
#pragma unroll
            for (int bj = 0; bj < 2; ++bj) {
                const u32x4 b = bb[it & 3][bj];
                const f32x4 x = acc[ai][bj][m][0], y = acc[ai][bj][m][1];
                u32x4 w; w.x = cvt_pk_bf16(x[0] * bflo(b.x), x[1] * bfhi(b.x)); w.y = cvt_pk_bf16(x[2] * bflo(b.y), x[3] * bfhi(b.y));
                w.z = cvt_pk_bf16(y[0] * bflo(b.z), y[1] * bfhi(b.z)); w.w = cvt_pk_bf16(y[2] * bflo(b.w), y[3] * bfhi(b.w));
                *(GAS u32x4*)(merged + ro + bj * 128) = w;
            }
            __builtin_amdgcn_sched_barrier(0);
        }
#undef EM_LOAD
    }
};

__device__ __forceinline__ float score_bound_neg(const float* gq, const float* gk, int lane) {
    float a = fmaxf(fabsf(gq[lane]), fabsf(gq[lane + 64])), b = fmaxf(fabsf(gk[lane]), fabsf(gk[lane + 64]));
#pragma unroll
    for (int off = 32; off >= 1; off >>= 1) { a = fmaxf(a, __shfl_xor(a, off)); b = fmaxf(b, __shfl_xor(b, off)); }
    return -(128.0f * QSCALE * 1.02f) * a * b;
}
constexpr int KP = 272, VP = 320, KBYTES = 64 * KP, VBYTES = 64 * VP, ASTAGE = KBYTES + VBYTES;

template <int MODE>
__device__ void attn_block(LAS unsigned char* lds, const bf16_t* Qp, const bf16_t* Kp, const bf16_t* Vp, int qb, const unsigned* maskp, const bf16_t* sga, bf16_t* outp, const float negMB) {
    const int tid = opaque_tid(), wid = __builtin_amdgcn_readfirstlane(tid >> 6), lane = tid & 63, c = lane & 31, h = lane >> 5;
    const int grp = wid >> 2;
    const int q0 = qb * 256 + wid * 32, qpos = q0 + c;
    bf16x8 qf[8];
#pragma unroll
    for (int ks = 0; ks < 8; ++ks) qf[ks] = *(const GAS bf16x8*)(Qp + (size_t)qpos * 1024 + ks * 16 + h * 8);
    f32x16 o[4];
#pragma unroll
    for (int d = 0; d < 4; ++d)
#pragma unroll
        for (int r = 0; r < 16; ++r) o[d][r] = 0.f;
    float lrun = 0.f;
    const int nt = 4 * (qb + 1);
    const int my_last = (q0 + 31) >> 6;
    const int srow = tid >> 4, sch = tid & 15;
    u32x4 kr[2], vr[2];
    bf16x8 pf[2][2];
#pragma unroll
    for (int a = 0; a < 2; ++a)
#pragma unroll
        for (int b = 0; b < 2; ++b) pf[a][b] = (bf16x8){0, 0, 0, 0, 0, 0, 0, 0};
#define ATT_GLOAD(j) do { _Pragma("unroll") for (int _i = 0; _i < 2; ++_i) { const size_t _o = (size_t)((j) * 64 + srow + 32 * _i) * 1024 + sch * 8; \
        kr[_i] = *(const GAS u32x4*)(Kp + _o); vr[_i] = *(const GAS u32x4*)(Vp + _o); } } while (0)
#define ATT_LSTORE(buf) do { _Pragma("unroll") for (int _i = 0; _i < 2; ++_i) { \
        *(LAS u32x4*)(lds + (buf) * ASTAGE + (srow + 32 * _i) * KP + sch * 16) = kr[_i]; \
        *(LAS u32x4*)(lds + (buf) * ASTAGE + KBYTES + (srow + 32 * _i) * VP + sch * 16) = vr[_i]; } } while (0)
#define ATT_PV(stage) do { LAS unsigned char* _vb = lds + (stage) * ASTAGE + KBYTES; __builtin_amdgcn_s_setprio(1); \
        _Pragma("unroll") for (int st = 0; st < 2; ++st) _Pragma("unroll") for (int s2 = 0; s2 < 2; ++s2) _Pragma("unroll") for (int d = 0; d < 4; ++d) { \
            const s16x4 lo = __builtin_amdgcn_ds_read_tr16_b64_v4i16((LAS s16x4*)(_vb + vread + (32 * st + 16 * s2) * VP + d * 64)); \
            const s16x4 hi = __builtin_amdgcn_ds_read_tr16_b64_v4i16((LAS s16x4*)(_vb + vread + (32 * st + 16 * s2 + 8) * VP + d * 64)); \
            const bf16x8 vf = __builtin_shufflevector(lo, hi, 0, 1, 2, 3, 4, 5, 6, 7); \
            o[d] = __builtin_amdgcn_mfma_f32_32x32x16_bf16(vf, pf[st][s2], o[d], 0, 0, 0); } \
        __builtin_amdgcn_sched_group_barrier(0x100, 6, 1); \
        _Pragma("unroll") for (int i = 0; i < 16; ++i) { __builtin_amdgcn_sched_group_barrier(0x008, 1, 1); __builtin_amdgcn_sched_group_barrier(0x100, 2, 1); } \
        __builtin_amdgcn_s_setprio(0); } while (0)
    ATT_GLOAD(0); ATT_LSTORE(0);
    const int kread = c * KP + h * 16;
    const int vread = (4 * h + ((lane & 15) >> 2)) * VP + ((lane >> 4) & 1) * 32 + (lane & 3) * 8;
    u32x4 mw4 = {0u, 0u, 0u, 0u};
    int sj = 0, sp = 2;
    for (int j = 0; j < nt; ++j) {
        lds_barrier();
        const int sn = (sj == 2) ? 0 : sj + 1;
        if (j + 1 < nt) ATT_GLOAD(j + 1);
        u32x2 mw = {0u, 0u};
        if (MODE == 0) {
            if ((j & 1) == 0) { if (j <= my_last) mw4 = *(const GAS u32x4*)(maskp + ((size_t)(j >> 1) * SEQ + qpos) * 4); mw.x = mw4.x; mw.y = mw4.y; }
            else { mw.x = mw4.z; mw.y = mw4.w; }
        }
        if (grp == 1 && j >= 1 && j - 1 <= my_last) ATT_PV(sp);
        if (j <= my_last) {
            LAS unsigned char* kb = lds + sj * ASTAGE;
            f32x16 s0, s1;
#pragma unroll
            for (int r = 0; r < 16; ++r) { s0[r] = negMB; s1[r] = negMB; }
#pragma unroll
            for (int ks = 0; ks < 8; ++ks) {
                const bf16x8 k0 = *(const LAS bf16x8*)(kb + kread + ks * 32);
                const bf16x8 k1 = *(const LAS bf16x8*)(kb + kread + 32 * KP + ks * 32);
                s0 = __builtin_amdgcn_mfma_f32_32x32x16_bf16(k0, qf[ks], s0, 0, 0, 0);
                s1 = __builtin_amdgcn_mfma_f32_32x32x16_bf16(k1, qf[ks], s1, 0, 0, 0);
            }
            __builtin_amdgcn_sched_group_barrier(0x100, 6, 0);
#pragma unroll
            for (int i = 0; i < 8; ++i) { __builtin_amdgcn_sched_group_barrier(0x008, 2, 0); __builtin_amdgcn_sched_group_barrier(0x100, 2, 0); }
            if (j * 64 + 63 > q0) {
                const int kbase = j * 64 + 4 * h;
#pragma unroll
                for (int r = 0; r < 16; ++r) { const int key = kbase + (r & 3) + 8 * (r >> 2);
                    if (key > qpos) s0[r] = -INFINITY; if (key + 32 > qpos) s1[r] = -INFINITY; }
            }
#pragma unroll
            for (int r = 0; r < 16; ++r) { s0[r] = fast_exp2(s0[r]); s1[r] = fast_exp2(s1[r]); }
            if (MODE == 0) {
#pragma unroll
                for (int r = 0; r < 16; ++r) { const int bit = (r & 3) + 8 * (r >> 2) + 4 * h;
                    const int m0 = __builtin_amdgcn_sbfe((int)mw.x, bit, 1), m1 = __builtin_amdgcn_sbfe((int)mw.y, bit, 1);
                    s0[r] = __int_as_float(__float_as_int(s0[r]) & m0); s1[r] = __int_as_float(__float_as_int(s1[r]) & m1); }
            }
            float ls = 0.f;
#pragma unroll
            for (int r = 0; r < 16; ++r) ls += s0[r] + s1[r];
            lrun += ls;
#pragma unroll
            for (int s2 = 0; s2 < 2; ++s2) {
                u32x4 w0, w1;
                w0.x = cvt_pk_bf16(s0[8 * s2 + 0], s0[8 * s2 + 1]); w0.y = cvt_pk_bf16(s0[8 * s2 + 2], s0[8 * s2 + 3]); w0.z = cvt_pk_bf16(s0[8 * s2 + 4], s0[8 * s2 + 5]); w0.w = cvt_pk_bf16(s0[8 * s2 + 6], s0[8 * s2 + 7]);
                w1.x = cvt_pk_bf16(s1[8 * s2 + 0], s1[8 * s2 + 1]); w1.y = cvt_pk_bf16(s1[8 * s2 + 2], s1[8 * s2 + 3]); w1.z = cvt_pk_bf16(s1[8 * s2 + 4], s1[8 * s2 + 5]); w1.w = cvt_pk_bf16(s1[8 * s2 + 6], s1[8 * s2 + 7]);
                pf[0][s2] = __builtin_bit_cast(bf16x8, w0); pf[1][s2] = __builtin_bit_cast(bf16x8, w1);
            }
            if (grp == 0) ATT_PV(sj);
        }
        if (j + 1 < nt) ATT_LSTORE(sn);
        sp = sj; sj = sn;
    }
    if (grp == 1 && nt - 1 <= my_last) ATT_PV(sp);
#undef ATT_GLOAD
#undef ATT_LSTORE
#undef ATT_PV
    const float ltot = lrun + __shfl_xor(lrun, 32);
    const float inv = 1.0f / ltot;
#pragma unroll
    for (int d = 0; d < 4; ++d)
#pragma unroll
        for (int g = 0; g < 4; ++g) {
            const int dd = 32 * d + 8 * g + 4 * h;
            float v0 = o[d][4 * g] * inv, v1 = o[d][4 * g + 1] * inv, v2 = o[d][4 * g + 2] * inv, v3 = o[d][4 * g + 3] * inv;
            if (MODE == 0) {
                const u32x2 gw = *(const GAS u32x2*)(sga + (size_t)qpos * 1024 + dd);
                v0 *= bflo(gw.x); v1 *= bfhi(gw.x); v2 *= bflo(gw.y); v3 *= bfhi(gw.y);
                u32x2 w; w.x = cvt_pk_bf16(v0, v1); w.y = cvt_pk_bf16(v2, v3);
                *(GAS u32x2*)(outp + (size_t)qpos * 2048 + dd) = w;
            } else {
                u32x2 w; w.x = cvt_pk_bf16(v0, v1); w.y = cvt_pk_bf16(v2, v3);
                *(GAS u32x2*)(outp + (size_t)qpos * 2048 + dd) = w;
            }
        }
    __syncthreads();
}

constexpr int VP2 = 576, VB2 = 64 * VP2, PSTAGE = KBYTES + VB2  , XBUF_OFF = 2 * PSTAGE  ;
__device__ void attn_pair_block(LAS unsigned char* lds, const bf16_t* Qp, const bf16_t* Kp, const bf16_t* Vp, int qb, bf16_t* outp, const float negMB) {
    const int tid = opaque_tid(), wid = __builtin_amdgcn_readfirstlane(tid >> 6), lane = tid & 63, c = lane & 31, h = lane >> 5;
    const int stw = wid >> 2;
    const int q0 = qb * 128 + (wid & 3) * 32, qpos = q0 + c;
    bf16x8 qf[8];
#pragma unroll
    for (int ks = 0; ks < 8; ++ks) qf[ks] = *(const GAS bf16x8*)(Qp + (size_t)qpos * 1024 + ks * 16 + h * 8);
    f32x16 o[4];
#pragma unroll
    for (int d = 0; d < 4; ++d)
#pragma unroll
        for (int r = 0; r < 16; ++r) o[d][r] = 0.f;
    float lrun = 0.f;
    const int nt = 2 * (qb + 1);
    const int my_last = (q0 + 31) >> 6;
    u32x4 kr[2], vr[4];
#define PB_GLOAD(j) do { _Pragma("unroll") for (int _i = 0; _i < 2; ++_i) { const int _id = tid + 512 * _i; \
            kr[_i] = *(const GAS u32x4*)(Kp + (size_t)((j) * 64 + (_id >> 4)) * 1024 + (_id & 15) * 8); } \
        _Pragma("unroll") for (int _i = 0; _i < 4; ++_i) { const int _id = tid + 512 * _i; \
            vr[_i] = *(const GAS u32x4*)(Vp + (size_t)((j) * 64 + (_id >> 5)) * 1024 + (_id & 31) * 8); } } while (0)
#define PB_LSTORE(buf) do { _Pragma("unroll") for (int _i = 0; _i < 2; ++_i) { const int _id = tid + 512 * _i; \
            *(LAS u32x4*)(lds + (buf) * PSTAGE + (_id >> 4) * KP + (_id & 15) * 16) = kr[_i]; } \
        _Pragma("unroll") for (int _i = 0; _i < 4; ++_i) { const int _id = tid + 512 * _i; \
            *(LAS u32x4*)(lds + (buf) * PSTAGE + KBYTES + (_id >> 5) * VP2 + (_id & 31) * 16) = vr[_i]; } } while (0)
    PB_GLOAD(0); PB_LSTORE(0);
    __syncthreads();
    const int kread = (32 * stw + c) * KP + h * 16;
    const int vread = (4 * h + ((lane & 15) >> 2)) * VP2 + stw * 256 + ((lane >> 4) & 1) * 32 + (lane & 3) * 8;
    LAS unsigned char* xmine = lds + XBUF_OFF + wid * 2048 + lane * 16;
    const LAS unsigned char* xother = lds + XBUF_OFF + (wid ^ 4) * 2048 + lane * 16;
    for (int j = 0; j < nt; ++j) {
        LAS unsigned char* kb = lds + (j & 1) * PSTAGE; LAS unsigned char* vb = kb + KBYTES;
        if (j + 1 < nt) PB_GLOAD(j + 1);
        const bool act = j <= my_last;
        bf16x8 pown[2];
        if (act) {
            f32x16 s0;
#pragma unroll
            for (int r = 0; r < 16; ++r) s0[r] = negMB;
#pragma unroll
            for (int ks = 0; ks < 8; ++ks) { const bf16x8 k0 = *(const LAS bf16x8*)(kb + kread + ks * 32); s0 = __builtin_amdgcn_mfma_f32_32x32x16_bf16(k0, qf[ks], s0, 0, 0, 0); }
            __builtin_amdgcn_sched_group_barrier(0x100, 3, 0);
#pragma unroll
            for (int i = 0; i < 8; ++i) { __builtin_amdgcn_sched_group_barrier(0x008, 1, 0); __builtin_amdgcn_sched_group_barrier(0x100, 1, 0); }
            if (j * 64 + 63 > q0) {
                const int kbase = j * 64 + 32 * stw + 4 * h;
#pragma unroll
                for (int r = 0; r < 16; ++r) { const int key = kbase + (r & 3) + 8 * (r >> 2); if (key > qpos) s0[r] = -INFINITY; }
            }
#pragma unroll
            for (int r = 0; r < 16; ++r) s0[r] = fast_exp2(s0[r]);
            float ls = 0.f;
#pragma unroll
            for (int r = 0; r < 16; ++r) ls += s0[r];
            lrun += ls;
#pragma unroll
            for (int s2 = 0; s2 < 2; ++s2) { u32x4 w0;
                w0.x = cvt_pk_bf16(s0[8 * s2 + 0], s0[8 * s2 + 1]); w0.y = cvt_pk_bf16(s0[8 * s2 + 2], s0[8 * s2 + 3]); w0.z = cvt_pk_bf16(s0[8 * s2 + 4], s0[8 * s2 + 5]); w0.w = cvt_pk_bf16(s0[8 * s2 + 6], s0[8 * s2 + 7]);
                pown[s2] = __builtin_bit_cast(bf16x8, w0); *(LAS u32x4*)(xmine + s2 * 1024) = w0; }
        }
        lds_barrier();
        if (act) {
            bf16x8 poth[2];
#pragma unroll
            for (int s2 = 0; s2 < 2; ++s2) poth[s2] = *(const LAS bf16x8*)(xother + s2 * 1024);
            __builtin_amdgcn_s_setprio(1);
#pragma unroll
            for (int st = 0; st < 2; ++st)
#pragma unroll
                for (int s2 = 0; s2 < 2; ++s2)
#pragma unroll
                    for (int d = 0; d < 4; ++d) {
                        const s16x4 lo = __builtin_amdgcn_ds_read_tr16_b64_v4i16((LAS s16x4*)(vb + vread + (32 * st + 16 * s2) * VP2 + d * 64));
                        const s16x4 hi = __builtin_amdgcn_ds_read_tr16_b64_v4i16((LAS s16x4*)(vb + vread + (32 * st + 16 * s2 + 8) * VP2 + d * 64));
                        const bf16x8 vf = __builtin_shufflevector(lo, hi, 0, 1, 2, 3, 4, 5, 6, 7);
                        const bf16x8 pfr = (st == stw) ? pown[s2] : poth[s2];
                        o[d] = __builtin_amdgcn_mfma_f32_32x32x16_bf16(vf, pfr, o[d], 0, 0, 0);
                    }
            __builtin_amdgcn_sched_group_barrier(0x100, 8, 1);
#pragma unroll
            for (int i = 0; i < 16; ++i) { __builtin_amdgcn_sched_group_barrier(0x008, 1, 1); __builtin_amdgcn_sched_group_barrier(0x100, 2, 1); }
            __builtin_amdgcn_s_setprio(0);
        }
        if (j + 1 < nt) PB_LSTORE((j + 1) & 1);
        lds_barrier();
    }
#undef PB_GLOAD
#undef PB_LSTORE
    float lown = lrun + __shfl_xor(lrun, 32);
    *(LAS float*)(xmine) = lown;
    __syncthreads();
    const float ltot = lown + *(const LAS float*)(xother);
    const float inv = 1.0f / ltot;
#pragma unroll
    for (int d = 0; d < 4; ++d)
#pragma unroll
        for (int g = 0; g < 4; ++g) {
            const int dd = stw * 128 + 32 * d + 8 * g + 4 * h;
            u32x2 w; w.x = cvt_pk_bf16(o[d][4 * g] * inv, o[d][4 * g + 1] * inv); w.y = cvt_pk_bf16(o[d][4 * g + 2] * inv, o[d][4 * g + 3] * inv);
            *(GAS u32x2*)(outp + (size_t)qpos * 2048 + dd) = w;
        }
    __syncthreads();
}

constexpr int IX_QP = 2192  , IX_CAND = 16 * IX_QP  , IX_CNT = IX_CAND + 16 * 512 * 8  ;
__device__ __forceinline__ unsigned lds_add(LAS unsigned* p, unsigned v) { return __hip_atomic_fetch_add(p, v, __ATOMIC_RELAXED, __HIP_MEMORY_SCOPE_WORKGROUP); }
__device__ __forceinline__ void lds_or(LAS unsigned* p, unsigned v) { __hip_atomic_fetch_or(p, v, __ATOMIC_RELAXED, __HIP_MEMORY_SCOPE_WORKGROUP); }
__device__ __forceinline__ unsigned f2key(float x) { const unsigned u = __float_as_uint(x); return (u & 0x80000000u) ? ~u : (u | 0x80000000u); }

template <bool EXACT>
__device__ void select256(LAS unsigned char* lds, int qi, int wid, int lane) {
    LAS u64* cand = (LAS u64*)(lds + IX_CAND) + qi * 512;
    LAS unsigned* cnt = (LAS unsigned*)(lds + IX_CNT);
    const int m = min((int)cnt[qi], 512);
    u64 e[8]; unsigned k[8];
#pragma unroll
    for (int i = 0; i < 8; ++i) { const int idx = lane + 64 * i; e[i] = idx < m ? cand[idx] : 0ull; k[i] = (unsigned)(e[i] >> 16); }
    unsigned T = 0u;
    int cT = m;
#pragma unroll 1
    for (int bit = 31; bit >= 0; --bit) {
        const unsigned trial = T | (1u << bit);
        int c = 0;
#pragma unroll
        for (int i = 0; i < 8; ++i) c += __builtin_popcountll(__ballot(k[i] >= trial));
        if (c >= 256) { T = trial; cT = c; }
        if (!EXACT && cT <= 320) break;
    }
    if (!EXACT) {
        int base = 0;
#pragma unroll
        for (int i = 0; i < 8; ++i) {
            const bool keep = k[i] >= T;
            const u64 bm = __ballot(keep);
            const int pos = base + __builtin_popcountll(bm & ((1ull << lane) - 1ull));
            if (keep) cand[pos] = e[i];
            base += __builtin_popcountll(bm);
        }
        if (lane == 0) { cnt[qi] = (unsigned)base; cnt[32 + qi] = T - 1u; }
        return;
    }
    int g = 0, eq = 0;
#pragma unroll
    for (int i = 0; i < 8; ++i) { g += __builtin_popcountll(__ballot(k[i] > T)); eq += __builtin_popcountll(__ballot(k[i] == T)); }
    const int needeq = 256 - g;
    unsigned L = 0u;
    if (eq > needeq) {
#pragma unroll 1
        for (int bit = 15; bit >= 0; --bit) {
            const unsigned trial = L | (1u << bit);
            int c = 0;
#pragma unroll
            for (int i = 0; i < 8; ++i) c += __builtin_popcountll(__ballot(k[i] == T && (unsigned)(e[i] & 0xFFFFull) >= trial));
            if (c >= needeq) L = trial;
        }
    }
    const u64 thr = ((u64)T << 16) | (u64)L;
    int base = 0;
#pragma unroll
    for (int i = 0; i < 8; ++i) {
        const bool keep = e[i] >= thr;
        const u64 bm = __ballot(keep);
        const int pos = base + __builtin_popcountll(bm & ((1ull << lane) - 1ull));
        if (keep) cand[pos] = e[i];
        base += __builtin_popcountll(bm);
    }
    if (lane == 0) { cnt[qi] = 256u; cnt[32 + qi] = T; }
}

__device__ void indexer_item(LAS unsigned char* lds, const bf16_t* Qi, const bf16_t* Ki, const float* Wi, unsigned* maskout, int qt) {
    const int tid = opaque_tid(), wid = __builtin_amdgcn_readfirstlane(tid >> 6), lane = tid & 63, q = lane & 15, quad = lane >> 4;
    const int t0 = qt * 16;
    LAS unsigned* cnt = (LAS unsigned*)(lds + IX_CNT);
    LAS u64* cand = (LAS u64*)(lds + IX_CAND);
#pragma unroll
    for (int i = 0; i < 4; ++i) { const int id = tid + 512 * i, row = id >> 7, ch = id & 127;
        *(LAS u32x4*)(lds + row * IX_QP + ch * 16) = *(const GAS u32x4*)(Qi + (size_t)(t0 + row) * 1024 + ch * 8); }
    if (tid < 64) cnt[tid] = 0u;
    float wv[16];
#pragma unroll
    for (int i = 0; i < 4; ++i) { const f32x4 w4 = *(const GAS f32x4*)(Wi + (size_t)(t0 + q) * 16 + i * 4); wv[4 * i] = 0.5f * w4[0]; wv[4 * i + 1] = 0.5f * w4[1]; wv[4 * i + 2] = 0.5f * w4[2]; wv[4 * i + 3] = 0.5f * w4[3]; }
    f32x4 wq[4];
#pragma unroll
    for (int i = 0; i < 4; ++i) wq[i] = *(const GAS f32x4*)(Wi + (size_t)(t0 + (tid >> 5)) * 16 + i * 4);
    bf16x8 kn[2][2];
#pragma unroll
    for (int st = 0; st < 2; ++st)
#pragma unroll
        for (int ks = 0; ks < 2; ++ks) kn[st][ks] = *(const GAS bf16x8*)(Ki + (size_t)(wid * 32 + 16 * st + q) * 64 + ks * 32 + quad * 8);
    __syncthreads();
    {
        const int qr = tid >> 5, dp = tid & 31;
        float e0 = 0.f, e1 = 0.f;
#pragma unroll
        for (int i = 0; i < 4; ++i) { const f32x4 w4 = wq[i];
#pragma unroll
            for (int jj = 0; jj < 4; ++jj) { const unsigned v = *(const LAS unsigned*)(lds + qr * IX_QP + (4 * i + jj) * 128 + dp * 4); e0 += w4[jj] * bflo(v); e1 += w4[jj] * bfhi(v); } }
        *(LAS unsigned*)(lds + qr * IX_QP + 16 * 128 + dp * 4) = cvt_pk_bf16(0.5f * e0, 0.5f * e1);
    }
    __syncthreads();
    const int niter = (t0 + 16 + 255) >> 8;
    const int tq = t0 + q;
    const LAS unsigned char* qrow = lds + q * IX_QP + quad * 16;
    unsigned thr = 0u;
    for (int it = 0; it < niter; ++it) {
        const int kb = it * 256 + wid * 32;
        bf16x8 kf[2][2];
#pragma unroll
        for (int st = 0; st < 2; ++st)
#pragma unroll
            for (int ks = 0; ks < 2; ++ks) kf[st][ks] = kn[st][ks];
        { const int itn = (it + 1 < niter) ? it + 1 : it; const int kbn = itn * 256 + wid * 32;
#pragma unroll
          for (int st = 0; st < 2; ++st)
#pragma unroll
            for (int ks = 0; ks < 2; ++ks) kn[st][ks] = *(const GAS bf16x8*)(Ki + (size_t)(kbn + 16 * st + q) * 64 + ks * 32 + quad * 8); }
        const f32x4 z4 = {0.f, 0.f, 0.f, 0.f};
        f32x4 sc0, sc1, c0, c1;
        { const bf16x8 qa = *(const LAS bf16x8*)(qrow + 16 * 128), qb2 = *(const LAS bf16x8*)(qrow + 16 * 128 + 64);
          sc0 = __builtin_amdgcn_mfma_f32_16x16x32_bf16(kf[0][0], qa, z4, 0, 0, 0); sc0 = __builtin_amdgcn_mfma_f32_16x16x32_bf16(kf[0][1], qb2, sc0, 0, 0, 0);
          sc1 = __builtin_amdgcn_mfma_f32_16x16x32_bf16(kf[1][0], qa, z4, 0, 0, 0); sc1 = __builtin_amdgcn_mfma_f32_16x16x32_bf16(kf[1][1], qb2, sc1, 0, 0, 0); }
        { const bf16x8 qa = *(const LAS bf16x8*)(qrow), qb2 = *(const LAS bf16x8*)(qrow + 64);
          c0 = __builtin_amdgcn_mfma_f32_16x16x32_bf16(kf[0][0], qa, z4, 0, 0, 0); c0 = __builtin_amdgcn_mfma_f32_16x16x32_bf16(kf[0][1], qb2, c0, 0, 0, 0);
          c1 = __builtin_amdgcn_mfma_f32_16x16x32_bf16(kf[1][0], qa, z4, 0, 0, 0); c1 = __builtin_amdgcn_mfma_f32_16x16x32_bf16(kf[1][1], qb2, c1, 0, 0, 0); }
#pragma unroll
        for (int hd = 0; hd < 16; ++hd) {
            f32x4 n0 = z4, n1 = z4;
            if (hd < 15) {
                const bf16x8 qa = *(const LAS bf16x8*)(qrow + (hd + 1) * 128), qb2 = *(const LAS bf16x8*)(qrow + (hd + 1) * 128 + 64);
                n0 = __builtin_amdgcn_mfma_f32_16x16x32_bf16(kf[0][0], qa, z4, 0, 0, 0); n0 = __builtin_amdgcn_mfma_f32_16x16x32_bf16(kf[0][1], qb2, n0, 0, 0, 0);
                n1 = __builtin_amdgcn_mfma_f32_16x16x32_bf16(kf[1][0], qa, z4, 0, 0, 0); n1 = __builtin_amdgcn_mfma_f32_16x16x32_bf16(kf[1][1], qb2, n1, 0, 0, 0);
            }
            if (hd < 15)
                asm volatile("v_fma_f32 %0, %16, |%8|, %0\n\tv_fma_f32 %1, %16, |%9|, %1\n\tv_fma_f32 %2, %16, |%10|, %2\n\tv_fma_f32 %3, %16, |%11|, %3\n\t"
                             "v_fma_f32 %4, %16, |%12|, %4\n\tv_fma_f32 %5, %16, |%13|, %5\n\tv_fma_f32 %6, %16, |%14|, %6\n\tv_fma_f32 %7, %16, |%15|, %7"
                             : "+v"(sc0[0]), "+v"(sc0[1]), "+v"(sc0[2]), "+v"(sc0[3]), "+v"(sc1[0]), "+v"(sc1[1]), "+v"(sc1[2]), "+v"(sc1[3])
                             : "v"(c0[0]), "v"(c0[1]), "v"(c0[2]), "v"(c0[3]), "v"(c1[0]), "v"(c1[1]), "v"(c1[2]), "v"(c1[3]), "v"(wv[hd]), "v"(n0), "v"(n1));
            else
                asm volatile("s_nop 15\n\ts_nop 15\n\t"
                             "v_fma_f32 %0, %16, |%8|, %0\n\tv_fma_f32 %1, %16, |%9|, %1\n\tv_fma_f32 %2, %16, |%10|, %2\n\tv_fma_f32 %3, %16, |%11|, %3\n\t"
                             "v_fma_f32 %4, %16, |%12|, %4\n\tv_fma_f32 %5, %16, |%13|, %5\n\tv_fma_f32 %6, %16, |%14|, %6\n\tv_fma_f32 %7, %16, |%15|, %7"
                             : "+v"(sc0[0]), "+v"(sc0[1]), "+v"(sc0[2]), "+v"(sc0[3]), "+v"(sc1[0]), "+v"(sc1[1]), "+v"(sc1[2]), "+v"(sc1[3])
                             : "v"(c0[0]), "v"(c0[1]), "v"(c0[2]), "v"(c0[3]), "v"(c1[0]), "v"(c1[1]), "v"(c1[2]), "v"(c1[3]), "v"(wv[hd]));
            c0 = n0; c1 = n1;
        }
        unsigned k32[8]; int keyi[8];
#pragma unroll
        for (int j = 0; j < 4; ++j) { k32[j] = f2key(sc0[j]); k32[4 + j] = f2key(sc1[j]); keyi[j] = kb + quad * 4 + j; keyi[4 + j] = kb + 16 + quad * 4 + j; }
        int np = 0;
#pragma unroll
        for (int j = 0; j < 8; ++j) np += (keyi[j] <= tq && k32[j] > thr) ? 1 : 0;
        const int cnoff = (it & 1) ? 48 : 16;
        if (np) lds_add(cnt + cnoff + q, (unsigned)np);
        lds_barrier();
        bool round;
        {
            const unsigned both = (lane < 16) ? cnt[lane] + cnt[cnoff + lane] : 0u;
            if (tid < 16) cnt[(cnoff ^ 32) + tid] = 0u;
            round = __ballot(both > 512u) != 0ull;
            if (round) {
#pragma unroll 1
                for (int qq = 0; qq < 2; ++qq) { const int qi = 2 * wid + qq; const unsigned cc = cnt[qi], cn = cnt[cnoff + qi];
                    if (cc + cn > 512u || cc > 320u) {
                        if (cn > 192u || cc <= 320u) select256<true>(lds, qi, wid, lane); else select256<false>(lds, qi, wid, lane); } }
            }
        }
        lds_barrier();
        if (round) thr = cnt[32 + q];
#pragma unroll
        for (int j = 0; j < 8; ++j) if (keyi[j] <= tq && k32[j] > thr) {
            const unsigned pos = lds_add(cnt + q, 1u);
            if (pos < 512u) cand[q * 512 + pos] = ((u64)k32[j] << 16) | (u64)(16383 - keyi[j]);
        }
    }
    __syncthreads();
#pragma unroll 1
    for (int qq = 0; qq < 2; ++qq) { const int qi = 2 * wid + qq; if (cnt[qi] > 256u) select256<true>(lds, qi, wid, lane); }
    __syncthreads();
    LAS unsigned* rows = (LAS unsigned*)lds;
#pragma unroll
    for (int i = 0; i < 4; ++i) *(LAS u32x4*)(rows + (tid + 512 * i) * 4) = (u32x4){0u, 0u, 0u, 0u};
    __syncthreads();
#pragma unroll 1
    for (int qq = 0; qq < 2; ++qq) { const int qi = 2 * wid + qq; const int n = min((int)cnt[qi], 256);
        for (int e = lane; e < n; e += 64) { const u64 ent = cand[qi * 512 + e]; const int key = 16383 - (int)(ent & 0xFFFFull);
            lds_or(rows + qi * 512 + (key >> 5), 1u << (key & 31)); } }
    __syncthreads();
#pragma unroll
    for (int i = 0; i < 4; ++i) { const int id = tid + 512 * i, row = id & 15, jp = id >> 4;
        *(GAS u32x4*)(maskout + ((size_t)jp * SEQ + t0 + row) * 4) = *(const LAS u32x4*)(rows + row * 512 + jp * 4); }
    __syncthreads();
}

__device__ void combine_b(const Params& p) {
    const int tid = opaque_tid(), wid = tid >> 6, lane = tid & 63;
    float s1 = p.lq1[lane] * p.lk1[lane] + p.lq1[lane + 64] * p.lk1[lane + 64];
    float s2 = p.lq2[lane] * p.lk2[lane] + p.lq2[lane + 64] * p.lk2[lane + 64];
#pragma unroll
    for (int o = 32; o >= 1; o >>= 1) { s1 += __shfl_xor(s1, o); s2 += __shfl_xor(s2, o); }
    const float lam = expf(s1) - expf(s2) + 0.2f;
    const bf16_t* ob = (const bf16_t*)((unsigned char*)p.out + DO_OB);
    const bf16_t* sgb = (const bf16_t*)(p.ws + WS_SGB);
    bf16_t* ub = (bf16_t*)(p.ws + WS_UA) + 1024;
    const f32x4 g = *(const GAS f32x4*)(p.subln + lane * 4);
    const int gw = blockIdx.x * 8 + wid, nw = gridDim.x * 8;
    for (int n = gw; n < NTOK; n += nw) {
        u32x2 a[4], b[4], gt[4];
#pragma unroll
        for (int hb = 0; hb < 4; ++hb) {
            a[hb] = *(const GAS u32x2*)(ob + (size_t)n * 2048 + (hb * 2) * 256 + lane * 4);
            b[hb] = *(const GAS u32x2*)(ob + (size_t)n * 2048 + (hb * 2 + 1) * 256 + lane * 4);
            gt[hb] = *(const GAS u32x2*)(sgb + (size_t)n * 1024 + hb * 256 + lane * 4); }
        float v[4][4], ss[4];
#pragma unroll
        for (int hb = 0; hb < 4; ++hb) {
            v[hb][0] = bflo(a[hb].x) - lam * bflo(b[hb].x); v[hb][1] = bfhi(a[hb].x) - lam * bfhi(b[hb].x);
            v[hb][2] = bflo(a[hb].y) - lam * bflo(b[hb].y); v[hb][3] = bfhi(a[hb].y) - lam * bfhi(b[hb].y);
            ss[hb] = v[hb][0] * v[hb][0] + v[hb][1] * v[hb][1] + v[hb][2] * v[hb][2] + v[hb][3] * v[hb][3]; }
#pragma unroll
        for (int o = 32; o >= 1; o >>= 1) {
#pragma unroll
            for (int hb = 0; hb < 4; ++hb) ss[hb] += __shfl_xor(ss[hb], o); }
#pragma unroll
        for (int hb = 0; hb < 4; ++hb) {
            const float r = rsqrtf(ss[hb] * (1.0f / 256.f) + 1e-5f) * 0.8f;
            u32x2 w; w.x = cvt_pk_bf16(v[hb][0] * r * g[0] * bflo(gt[hb].x), v[hb][1] * r * g[1] * bfhi(gt[hb].x));
            w.y = cvt_pk_bf16(v[hb][2] * r * g[2] * bflo(gt[hb].y), v[hb][3] * r * g[3] * bfhi(gt[hb].y));
            *(GAS u32x2*)(ub + (size_t)n * 2048 + hb * 256 + lane * 4) = w; }
    }
}

__global__ void __launch_bounds__(512, 2) mega(Params p_unused) {
    KQ kp = (KQ)__builtin_amdgcn_kernarg_segment_ptr();
    extern __shared__ __attribute__((aligned(16))) unsigned char lds_raw[];
    LAS unsigned char* lds = (LAS unsigned char*)lds_raw;
    cg::grid_group grid = cg::this_grid();
    LAS int* item_slot = (LAS int*)(lds + ITEM_OFF);

    if (blockIdx.x == 0 && threadIdx.x < 64) ((unsigned*)load_params(kp).ws)[threadIdx.x] = 0u;
#ifndef SKIP_P0
    { const Params p = load_params(kp); prep_phase(p, lds); }
#endif
    grid.sync();
#ifndef SKIP_P1
    {
        const Params p = load_params(kp); unsigned char* dout = (unsigned char*)p.out;
        pg8::Gemm g{(const bf16_t*)(dout + DO_H), (const bf16_t*)(p.ws + WS_WINT), NTOK, NP, DM};
        pg8::StaticOrder S; S.init(NTOK, NP, gridDim.x, blockIdx.x);
        EpiIn E{p.ws, (const float*)(dout + DO_COSA), (const float*)(dout + DO_SINA), (const float*)(dout + DO_COSI), (const float*)(dout + DO_SINI),
                p.a_q_gain, p.a_k_gain, p.b_q_gain, p.b_k_gain, (LAS float*)(lds + 131072)};
        pg8::gemm_phase(lds, g, S, E);
    }
#endif
    grid.sync();
#define FETCH_ITEM(base, nitems) do { \
        __syncthreads(); \
        if (tid == 0) { int it, k = xk; for (;;) { const int qx = (xcd + k) & 7; it = (int)atomicAdd(ctr + (base) + qx, 1u); \
                if (it < (nitems)) { it |= qx << 16; break; } if (++k == 8) { it = -1; break; } } \
            item_slot[0] = it; item_slot[1] = k; } \
        __syncthreads(); \
        item = item_slot[0]; xk = item_slot[1]; } while (0)
#ifndef SKIP_P2
    { int xk = 0; const int xcd = blockIdx.x & 7;
    float negMB_b; { const Params p0 = load_params(kp); negMB_b = score_bound_neg(p0.b_q_gain, p0.b_k_gain, threadIdx.x & 63); }
    for (;;) {
        const Params p = load_params(kp); unsigned char* dout = (unsigned char*)p.out; unsigned* ctr = (unsigned*)(p.ws + WS_CTR); const int tid = opaque_tid();
        int item;
        FETCH_ITEM(0, 512);
        if (item < 0) break;
        const int qx = item >> 16, n = item & 0xFFFF;
        if (n < 256) {
            const int qb = 127 - (n >> 1), map = n & 1, b = qx & 1, hb = qx >> 1;
            const size_t tok0 = (size_t)b * SEQ;
            const bf16_t* Q = (const bf16_t*)(p.ws + WS_QB) + tok0 * 1024 + (hb * 2 + map) * 128;
            const bf16_t* K = (const bf16_t*)(p.ws + WS_KB) + tok0 * 1024 + (hb * 2 + map) * 128;
            const bf16_t* V = (const bf16_t*)(p.ws + WS_VB) + tok0 * 1024 + hb * 256;
            bf16_t* O = (bf16_t*)(dout + DO_OB) + tok0 * 2048 + (hb * 2 + map) * 256;
            attn_pair_block(lds, Q, K, V, qb, O, negMB_b);
        } else {
            const int i2 = (n - 256) * 8 + qx, qt = 1023 - (i2 >> 1), b = i2 & 1;
            const size_t tok0 = (size_t)b * SEQ;
            indexer_item(lds, (const bf16_t*)(p.ws + WS_QI) + tok0 * 1024, (const bf16_t*)(p.ws + WS_KI) + tok0 * 64, (const float*)(p.ws + WS_WI) + tok0 * 16,
                         (unsigned*)(dout + DO_MASK) + tok0 * 512, qt);
        }
    } }
#endif
    grid.sync();
#ifndef SKIP_P3
    { const Params p = load_params(kp); combine_b(p); }
    { int xk = 0; const int xcd = blockIdx.x & 7;
    float negMB_a; { const Params p0 = load_params(kp); negMB_a = score_bound_neg(p0.a_q_gain, p0.a_k_gain, threadIdx.x & 63); }
    for (;;) {
        const Params p = load_params(kp); unsigned char* dout = (unsigned char*)p.out; unsigned* ctr = (unsigned*)(p.ws + WS_CTR); const int tid = opaque_tid();
        int item;
        FETCH_ITEM(8, 128);
        if (item < 0) break;
        const int qx = item >> 16, n = item & 0xFFFF;
        const int qb = 63 - (n >> 1), idx = qx + 8 * (n & 1), b = idx & 1, hd = idx >> 1;
        const size_t tok0 = (size_t)b * SEQ;
        attn_block<0>(lds, (const bf16_t*)(p.ws + WS_QA) + tok0 * 1024 + hd * 128, (const bf16_t*)(p.ws + WS_KA) + tok0 * 1024 + hd * 128,
                      (const bf16_t*)(p.ws + WS_VA) + tok0 * 1024 + hd * 128, qb, (const unsigned*)(dout + DO_MASK) + tok0 * 512,
                      (const bf16_t*)(p.ws + WS_SGA) + tok0 * 1024 + hd * 128, (bf16_t*)(p.ws + WS_UA) + tok0 * 2048 + hd * 128, negMB_a);
    } }
#endif
#undef FETCH_ITEM
    grid.sync();
#ifndef SKIP_P4
    {
        const Params p = load_params(kp);
        pg8::StaticOrder S; S.init(NTOK, DM, gridDim.x, blockIdx.x);
        pg8::Gemm gab{(const bf16_t*)(p.ws + WS_UA), (const bf16_t*)(p.ws + WS_WOAT), NTOK, DM, DM};
        EpiMerge Em{(const bf16_t*)(p.ws + WS_SMA), (const bf16_t*)(p.ws + WS_SMB), (bf16_t*)(p.ws + WS_MERGED)};
        pg8::gemm_phase(lds, gab, S, Em);
    }
#endif
    grid.sync();
#ifndef SKIP_P5
    {
        const Params p = load_params(kp);
        pg8::StaticOrder S; S.init(NTOK, DM, gridDim.x, blockIdx.x);
        pg8::Gemm go{(const bf16_t*)(p.ws + WS_MERGED), (const bf16_t*)(p.ws + WS_WOUTT), NTOK, DM, DM};
        EpiOut<2> Eo{nullptr, nullptr, nullptr, p.x, p.out};
        pg8::gemm_phase(lds, go, S, Eo);
    }
#endif
}

extern "C" void kernel_launch(void* const* d_in, const int* in_sizes, int n_in, void* d_out, int out_size, void* d_ws, size_t ws_size, hipStream_t stream) {
    static int grid_blocks = 0;
    if (!grid_blocks) {
        hipFuncSetAttribute((const void*)mega, hipFuncAttributeMaxDynamicSharedMemorySize, LDS_BYTES);
        int dev = 0, cus = 0, per_cu = 0;
        hipGetDevice(&dev);
        hipDeviceGetAttribute(&cus, hipDeviceAttributeMultiprocessorCount, dev);
        hipOccupancyMaxActiveBlocksPerMultiprocessor(&per_cu, mega, 512, LDS_BYTES);
        if (per_cu < 1) per_cu = 1;
        grid_blocks = cus * 1;
    }
    Params p{};
    p.x = (const float*)d_in[0]; p.pos = (const int*)d_in[1]; p.norm_gain = (const float*)d_in[2]; p.w_in = (const float*)d_in[3];
    p.a_q_gain = (const float*)d_in[4]; p.a_k_gain = (const float*)d_in[5]; p.b_q_gain = (const float*)d_in[6]; p.b_k_gain = (const float*)d_in[7];
    p.lq1 = (const float*)d_in[8]; p.lk1 = (const float*)d_in[9]; p.lq2 = (const float*)d_in[10]; p.lk2 = (const float*)d_in[11]; p.subln = (const float*)d_in[12];
    p.w_o_a = (const float*)d_in[13]; p.w_o_b = (const float*)d_in[14]; p.w_out = (const float*)d_in[15];
    p.out = (float*)d_out; p.ws = (unsigned char*)d_ws;
    void* args[] = {&p};
    hipError_t e = hipLaunchCooperativeKernel((void*)mega, dim3(grid_blocks), dim3(512), args, LDS_BYTES, stream);
    if (e != hipSuccess) fprintf(stderr, "cooperative launch failed: %s (grid %d)\n", hipGetErrorString(e), grid_blocks);
}
```
